# Optimizing an MI355X kernel written in HIP

```python
import jax, jax.numpy as jnp
from jax import lax
import numpy as np

D_MODEL = 2048
BATCH = 2
SEQ = 8192
DEPTH = 4
DEC_BATCH = 32
DEC_SEQ = 64
PAST_LEN = 1024

CHUNK = 64
HEAD_DIM = D_MODEL // 16
POOL_WINDOWS = (2, 4, 8, 16)
N_POOL_GROUPS = len(POOL_WINDOWS)
POOL_WIDTH = N_POOL_GROUPS * HEAD_DIM
N_CONV_HEADS = (3 * D_MODEL // 8) // HEAD_DIM
CONV_CH = N_CONV_HEADS * HEAD_DIM
CONV_K = 3
N_SGU_HEADS = (3 * D_MODEL // 8) // HEAD_DIM
SGU_WIDTH = N_SGU_HEADS * HEAD_DIM
SGU_LEN = 128
MIX_WIDTH = POOL_WIDTH + CONV_CH + SGU_WIDTH
IN_WIDTH = POOL_WIDTH + 3 * CONV_CH + 2 * SGU_WIDTH
D_FF = ((8 * D_MODEL // 3 + 255) // 256) * 256
POOL_STATE = max(POOL_WINDOWS) - 1
CONV_STATE = CONV_K - 1
N_NORMS = 6
EPS = 1e-6

kernel_name = "hybrid_pool_conv_sgu_streaming_step"


def rmsnorm(x, g):
    xf = x.astype(jnp.float32)
    y = xf * lax.rsqrt(jnp.mean(xf * xf, axis=-1, keepdims=True) + EPS)
    return (y * g.astype(jnp.float32)).astype(x.dtype)


def rms_plain(x):
    xf = x.astype(jnp.float32)
    return (xf * lax.rsqrt(jnp.mean(xf * xf, axis=-1, keepdims=True) + EPS)).astype(x.dtype)


def swiglu(x, wg, wu, wd):
    return (jax.nn.silu(x @ wg) * (x @ wu)) @ wd


def pool_mixer(p, hist, pos0, w_grp, scale):
    B, T, _ = p.shape
    ext = p if hist is None else jnp.concatenate([hist.astype(p.dtype), p], axis=1)
    H = ext.shape[1] - T
    cs = jnp.pad(jnp.cumsum(ext.astype(jnp.float32), axis=1), ((0, 0), (1, 0), (0, 0)))
    pf = p.astype(jnp.float32)
    t = np.arange(T)
    hi = t + H + 1
    outs = []
    for g, w in enumerate(POOL_WINDOWS):
        sl = slice(g * HEAD_DIM, (g + 1) * HEAD_DIM)
        lo = np.maximum(hi - w, 0)
        cnt = np.minimum(pos0 + t + 1, w).astype(np.float32)
        win_sum = cs[:, hi, sl] - cs[:, lo, sl]
        outs.append(win_sum / cnt[None, :, None] - pf[..., sl])
    d = jnp.stack(outs, axis=2)
    y = jnp.einsum('btgc,gcd->btgd', d, w_grp.astype(jnp.float32)).reshape(B, T, POOL_WIDTH)
    y = y * scale.astype(jnp.float32)
    return y.astype(p.dtype), ext[:, -POOL_STATE:]


def conv_mixer(h, bg, cg, hist, w_conv):
    T = h.shape[1]
    z = cg * h
    ext = jnp.concatenate([hist.astype(z.dtype), z], axis=1)
    y = ext[:, 0:T] * w_conv[0] + ext[:, 1:T + 1] * w_conv[1] + ext[:, 2:T + 2] * w_conv[2]
    return bg * y, ext[:, -CONV_STATE:]


def sgu_mixer(u, v, w_s, b_s):
    B, T, _ = u.shape
    n = -(-T // SGU_LEN)
    Tp = n * SGU_LEN
    vp = jnp.pad(v, ((0, 0), (0, Tp - T), (0, 0))).reshape(B, n, SGU_LEN, N_SGU_HEADS, HEAD_DIM)
    mask = jnp.tril(jnp.ones((SGU_LEN, SGU_LEN), dtype=bool))
    ws = jnp.where(mask[None], w_s, jnp.zeros_like(w_s))
    g = jnp.einsum('hst,bcthd->bcshd', ws, vp) + b_s.T[None, None, :, :, None]
    g = g.reshape(B, Tp, SGU_WIDTH)[:, :T]
    return u * g


def trunk_layer(x, pool_hist, conv_hist, pos0, w_in, w_out, pool_w, pool_scale, conv_w,
                sgu_w, sgu_b, f1g, f1u, f1d, f2g, f2u, f2d, ng, mix_g):
    x = x + 0.5 * rmsnorm(swiglu(rmsnorm(x, ng[0]), f1g, f1u, f1d), ng[1])
    proj = rmsnorm(x, ng[2]) @ w_in
    splits = np.cumsum([POOL_WIDTH, CONV_CH, CONV_CH, CONV_CH, SGU_WIDTH])
    p, h, bg, cg, u, v = jnp.split(proj, splits, axis=-1)
    ya, pool_new = pool_mixer(p, pool_hist, pos0, pool_w, pool_scale)
    yb, conv_new = conv_mixer(h, bg, cg, conv_hist, conv_w)
    yc = sgu_mixer(u, v, sgu_w, sgu_b)
    ymix = jnp.concatenate([rms_plain(ya), rms_plain(yb), rms_plain(yc)], axis=-1) * mix_g
    x = x + rmsnorm(ymix @ w_out, ng[3])
    x = x + 0.5 * rmsnorm(swiglu(rmsnorm(x, ng[4]), f2g, f2u, f2d), ng[5])
    return x, pool_new, conv_new, v


def setup_inputs(seed: int = 0) -> dict:
    key = jax.random.key(seed)
    ks = jax.random.split(key, 20)
    nrm = lambda k, shape, s: jax.random.normal(k, shape, jnp.float32) * s
    return {
        "x_prompt": nrm(ks[0], (BATCH, SEQ, D_MODEL), 1.0),
        "x_sample": nrm(ks[1], (DEC_BATCH, DEC_SEQ, D_MODEL), 1.0),
        "state_pool": nrm(ks[2], (DEPTH, DEC_BATCH, POOL_STATE, POOL_WIDTH), 1.0),
        "state_conv": nrm(ks[3], (DEPTH, DEC_BATCH, CONV_STATE, CONV_CH), 1.0),
        "w_in": nrm(ks[4], (DEPTH, D_MODEL, IN_WIDTH), D_MODEL ** -0.5),
        "w_out": nrm(ks[5], (DEPTH, MIX_WIDTH, D_MODEL), MIX_WIDTH ** -0.5),
        "pool_w": nrm(ks[6], (DEPTH, N_POOL_GROUPS, HEAD_DIM, HEAD_DIM), HEAD_DIM ** -0.5),
        "pool_scale": 1.0 + nrm(ks[7], (DEPTH, POOL_WIDTH), 0.1),
        "conv_w": nrm(ks[8], (DEPTH, CONV_K, CONV_CH), CONV_K ** -0.5),
        "sgu_w": nrm(ks[9], (DEPTH, N_SGU_HEADS, SGU_LEN, SGU_LEN), SGU_LEN ** -0.5),
        "sgu_b": 1.0 + nrm(ks[10], (DEPTH, N_SGU_HEADS, SGU_LEN), 0.1),
        "ffn1_gate": nrm(ks[11], (DEPTH, D_MODEL, D_FF), D_MODEL ** -0.5),
        "ffn1_up": nrm(ks[12], (DEPTH, D_MODEL, D_FF), D_MODEL ** -0.5),
        "ffn1_down": nrm(ks[13], (DEPTH, D_FF, D_MODEL), D_FF ** -0.5),
        "ffn2_gate": nrm(ks[14], (DEPTH, D_MODEL, D_FF), D_MODEL ** -0.5),
        "ffn2_up": nrm(ks[15], (DEPTH, D_MODEL, D_FF), D_MODEL ** -0.5),
        "ffn2_down": nrm(ks[16], (DEPTH, D_FF, D_MODEL), D_FF ** -0.5),
        "norm_gains": 1.0 + nrm(ks[17], (DEPTH, N_NORMS, D_MODEL), 0.1),
        "mix_gain": 1.0 + nrm(ks[18], (DEPTH, MIX_WIDTH), 0.1),
    }


def reference(x_prompt, x_sample, state_pool, state_conv, w_in, w_out, pool_w, pool_scale,
              conv_w, sgu_w, sgu_b, ffn1_gate, ffn1_up, ffn1_down, ffn2_gate, ffn2_up,
              ffn2_down, norm_gains, mix_gain):
    yp, ys = x_prompt, x_sample
    pool_p, conv_p, pool_s, conv_s, v_s = [], [], [], [], []
    conv_zero = jnp.zeros((BATCH, CONV_STATE, CONV_CH), x_prompt.dtype)
    for l in range(DEPTH):
        w = (w_in[l], w_out[l], pool_w[l], pool_scale[l], conv_w[l], sgu_w[l], sgu_b[l],
             ffn1_gate[l], ffn1_up[l], ffn1_down[l], ffn2_gate[l], ffn2_up[l], ffn2_down[l],
             norm_gains[l], mix_gain[l])
        yp, pp, cp, _ = trunk_layer(yp, None, conv_zero, 0, *w)
        ys, ps, cs, vs = trunk_layer(ys, state_pool[l], state_conv[l], PAST_LEN, *w)
        pool_p.append(pp); conv_p.append(cp)
        pool_s.append(ps); conv_s.append(cs); v_s.append(vs)
    new_pool_prompt = jnp.stack(pool_p, axis=0)
    new_conv_prompt = jnp.stack(conv_p, axis=0)
    new_pool_sample = jnp.stack(pool_s, axis=0)
    new_conv_sample = jnp.stack(conv_s, axis=0)
    new_sgu_v_sample = jnp.stack(v_s, axis=0)
    return (yp, ys, new_pool_prompt, new_conv_prompt, new_pool_sample, new_conv_sample, new_sgu_v_sample)
```

```cpp
#include <hip/hip_runtime.h>
#include <cstdio>
#include <cstdint>
namespace pg8 {
#define PG8_LAS __attribute__((address_space(3)))
typedef unsigned short bf16_t;
typedef short bf16x8 __attribute__((ext_vector_type(8)));
typedef float f32x4 __attribute__((ext_vector_type(4)));
typedef unsigned u32x4 __attribute__((ext_vector_type(4)));
constexpr int BM = 256, BK = 64, HALF = 128, HTB = HALF * BK * 2  , STAGE_BYTES = 8 * HTB, NXCD = 8, WGM = 8;

__host__ __device__ __forceinline__ int lds_byte(int r, int c) { const int st = (r >> 4) * 2 + (c >> 5), rr = r & 15, cc = c & 31, ob = rr * 64 + cc * 2; return st * 1024 + (ob ^ (((ob >> 9) & 1) << 5)); }
__host__ __device__ __forceinline__ void stage_rc(int b, int& R, int& C) { const int st = b / 1024, sb = b % 1024, swz = sb ^ (((sb >> 9) & 1) << 5); R = (st >> 1) * 16 + swz / 64; C = (st & 1) * 32 + (swz % 64) / 2; }
__host__ __device__ __forceinline__ int perm32(int rho) { const int n = rho >> 4, i = rho & 15; return 8 * (i >> 2) + 4 * n + (i & 3); }

struct Unit { int pm, pn; };
struct Gemm { const bf16_t* A; const bf16_t* Bt; int M, N, K; };

struct StaticOrder {
    int nM, nN, nwg, G, c;
    __host__ __device__ void init(int M, int N, int G_, int c_) { nM = M / BM; nN = N / BM; nwg = nM * nN; G = G_; c = c_; }
    __host__ __device__ bool next(int i, Unit& u) const {
        const long L = (long)i * G + c; if (L >= nwg) return false;
        int wgid = (int)L; { const int q = nwg / NXCD, r = nwg % NXCD, xcd = wgid % NXCD, off = wgid / NXCD; wgid = (xcd < r ? xcd * (q + 1) : r * (q + 1) + (xcd - r) * q) + off; }
        const int nig = WGM * nN, gid = wgid / nig, fm = gid * WGM, gsz = (nM - fm) < WGM ? (nM - fm) : WGM;
        u.pm = fm + ((wgid % nig) % gsz); u.pn = (wgid % nig) / gsz; return true;
    }
    __device__ __forceinline__ void a_ready(const Unit&) const {}
    __device__ __forceinline__ void done(const Unit&) const {}
};

__device__ __forceinline__ unsigned cvt_pk_bf16(float lo, float hi) { unsigned r; asm volatile("v_cvt_pk_bf16_f32 %0, %1, %2" : "=v"(r) : "v"(lo), "v"(hi)); return r; }
template <class Epi, class Sched, bool ALIGN_EPI = false, bool SP2 = false>
__device__ __forceinline__ void gemm_phase(PG8_LAS unsigned char* lds, const Gemm g, const Sched& S, const Epi& E, const int tid) {
    const int wid = __builtin_amdgcn_readfirstlane(tid >> 6), lane = tid & 63, wr = wid >> 2, wc = wid & 3, fr = lane & 15, fq = lane >> 4;
    const int K = g.K, nt = K / BK;
    unsigned voffA[2], voffB[2];
#pragma unroll
    for (int i = 0; i < 2; ++i) { int R, C; stage_rc(tid * 16 + i * 8192, R, C); const int Rb = Epi::PERM ? ((R & ~31) + perm32(R & 31)) : R;
        voffA[i] = (unsigned)(R * K + C) * 2u; voffB[i] = (unsigned)(Rb * K + C) * 2u; }
    const size_t kstep = (size_t)(BK * 2);
    const size_t hstep = (size_t)HALF * K * 2;
    const size_t tstep = 2 * hstep;
    const unsigned ldsw = (unsigned)wid * 1024u;
    const int aoff = lds_byte(wr * 64 + fr, fq * 8), boff = lds_byte(wc * 32 + fr, fq * 8);
#define PG8_SA(b, h) (((b) * 2 + (h)) * HTB)
#define PG8_SB(b, h) ((4 + (b) * 2 + (h)) * HTB)
#define PG8_STAGE(bufoff, gbase, voff) do { _Pragma("unroll") for (int _i = 0; _i < 2; ++_i) \
        __builtin_amdgcn_global_load_lds((const unsigned*)((const char*)(gbase) + (voff)[_i]), (PG8_LAS unsigned*)(lds + (bufoff) + ldsw + _i * 8192), 16, 0, 0); } while (0)
#define PG8_LDA(dst, b, h) do { _Pragma("unroll") for (int m = 0; m < 4; ++m) _Pragma("unroll") for (int k = 0; k < 2; ++k) dst[m][k] = *(const PG8_LAS bf16x8*)(lds + PG8_SA(b, h) + aoff + m * 2048 + k * 1024); } while (0)
#define PG8_LDB(dst, b, h) do { _Pragma("unroll") for (int n = 0; n < 2; ++n) _Pragma("unroll") for (int k = 0; k < 2; ++k) dst[n][k] = *(const PG8_LAS bf16x8*)(lds + PG8_SB(b, h) + boff + n * 2048 + k * 1024); } while (0)
#define PG8_MMA(ai, bj, At, Bt) do { __builtin_amdgcn_s_setprio(1); _Pragma("unroll") for (int m = 0; m < 4; ++m) _Pragma("unroll") for (int n = 0; n < 2; ++n) _Pragma("unroll") for (int k = 0; k < 2; ++k) \
        acc[ai][bj][m][n] = __builtin_amdgcn_mfma_f32_16x16x32_bf16(Bt[n][k], At[m][k], acc[ai][bj][m][n], 0, 0, 0); __builtin_amdgcn_s_setprio(0); } while (0)
#define PG8_WAIT_V(n) asm volatile("s_waitcnt vmcnt(" #n ")" ::: "memory")
#define PG8_WAIT_L(n) asm volatile("s_waitcnt lgkmcnt(" #n ")" ::: "memory")
#define PG8_BAR __builtin_amdgcn_s_barrier()
#define PG8_SCHED __builtin_amdgcn_sched_barrier(0)
    Unit cur, nxt; int ui = 0;
    if (!S.next(0, cur)) return;
    f32x4 acc[2][2][4][2];
#pragma unroll
    for (int a = 0; a < 2; ++a)
#pragma unroll
        for (int b = 0; b < 2; ++b)
#pragma unroll
            for (int m = 0; m < 4; ++m)
#pragma unroll
                for (int n = 0; n < 2; ++n) acc[a][b][m][n] = (f32x4){0.f, 0.f, 0.f, 0.f};
    bf16x8 At[4][2], B0[2][2], B1[2][2];
    const char* cA = (const char*)g.A + (size_t)cur.pm * tstep; const char* cB = (const char*)g.Bt + (size_t)cur.pn * tstep;
    S.a_ready(cur);
    if constexpr (SP2) {
        PG8_STAGE(PG8_SB(0, 0), cB, voffB); PG8_STAGE(PG8_SB(0, 1), cB + hstep, voffB); PG8_STAGE(PG8_SA(0, 0), cA, voffA); PG8_STAGE(PG8_SA(0, 1), cA + hstep, voffA);
        if (wr == 1) PG8_BAR;
        PG8_WAIT_V(2); PG8_BAR;
        PG8_STAGE(PG8_SB(1, 0), cB + kstep, voffB); PG8_STAGE(PG8_SA(1, 0), cA + kstep, voffA); PG8_STAGE(PG8_SB(1, 1), cB + hstep + kstep, voffB);
        PG8_WAIT_V(6); PG8_BAR;
    } else {
        PG8_STAGE(PG8_SB(0, 0), cB, voffB); PG8_STAGE(PG8_SA(0, 0), cA, voffA); PG8_STAGE(PG8_SB(0, 1), cB + hstep, voffB); PG8_STAGE(PG8_SA(0, 1), cA + hstep, voffA);
        if (wr == 1) PG8_BAR;
        PG8_WAIT_V(4); PG8_BAR;
        PG8_STAGE(PG8_SB(1, 0), cB + kstep, voffB); PG8_STAGE(PG8_SA(1, 0), cA + kstep, voffA); PG8_STAGE(PG8_SB(1, 1), cB + hstep + kstep, voffB);
        PG8_WAIT_V(6); PG8_BAR;
    }
    for (;;) {
        const bool has_next = S.next(ui + 1, nxt);
        const char* nA = has_next ? (const char*)g.A + (size_t)nxt.pm * tstep : cA; const char* nB = has_next ? (const char*)g.Bt + (size_t)nxt.pn * tstep : cB;
        for (int t = 0; t < nt; t += 2) {
            const bool last = (t == nt - 2);
            const char* a1 = cA + (size_t)(t + 1) * kstep;
            const char* a2 = last ? nA : cA + (size_t)(t + 2) * kstep; const char* b2 = last ? nB : cB + (size_t)(t + 2) * kstep;
            const char* a3 = a2 + kstep; const char* b3 = b2 + kstep;
            if (last && has_next) S.a_ready(nxt);
            if constexpr (SP2) {
            PG8_LDB(B0, 0, 0); PG8_LDB(B1, 0, 1); PG8_SCHED; PG8_LDA(At, 0, 0); PG8_STAGE(PG8_SA(1, 1), a1 + hstep, voffA);
            PG8_WAIT_V(8); PG8_WAIT_L(0); PG8_BAR; PG8_MMA(0, 0, At, B0); PG8_MMA(0, 1, At, B1); PG8_BAR; PG8_SCHED;
            PG8_LDA(At, 0, 1); PG8_STAGE(PG8_SB(0, 0), b2, voffB); PG8_STAGE(PG8_SB(0, 1), b2 + hstep, voffB); PG8_STAGE(PG8_SA(0, 0), a2, voffA);
            PG8_WAIT_V(8); PG8_WAIT_L(0); PG8_BAR; PG8_MMA(1, 0, At, B0); PG8_MMA(1, 1, At, B1); PG8_BAR; PG8_SCHED;
            PG8_LDB(B0, 1, 0); PG8_LDB(B1, 1, 1); PG8_SCHED; PG8_LDA(At, 1, 0); PG8_STAGE(PG8_SA(0, 1), a2 + hstep, voffA);
            PG8_WAIT_V(8); PG8_WAIT_L(0); PG8_BAR; PG8_MMA(0, 0, At, B0); PG8_MMA(0, 1, At, B1); PG8_BAR; PG8_SCHED;
            PG8_LDA(At, 1, 1); PG8_STAGE(PG8_SB(1, 0), b3, voffB); PG8_STAGE(PG8_SB(1, 1), b3 + hstep, voffB); PG8_STAGE(PG8_SA(1, 0), a3, voffA);
            PG8_WAIT_V(8); PG8_WAIT_L(0); PG8_BAR; PG8_MMA(1, 0, At, B0); PG8_MMA(1, 1, At, B1); PG8_BAR; PG8_SCHED;
            } else {
            PG8_LDB(B0, 0, 0); PG8_SCHED; PG8_LDA(At, 0, 0); PG8_STAGE(PG8_SA(1, 1), a1 + hstep, voffA);
            PG8_WAIT_L(8); PG8_BAR; PG8_WAIT_L(0); PG8_MMA(0, 0, At, B0); PG8_BAR; PG8_SCHED;
            PG8_LDB(B1, 0, 1); PG8_STAGE(PG8_SB(0, 0), b2, voffB);
            PG8_BAR; PG8_WAIT_L(0); PG8_MMA(0, 1, At, B1); PG8_BAR;
            PG8_LDA(At, 0, 1); PG8_STAGE(PG8_SA(0, 0), a2, voffA);
            PG8_BAR; PG8_WAIT_L(0); PG8_MMA(1, 0, At, B0); PG8_BAR; PG8_SCHED;
            PG8_STAGE(PG8_SB(0, 1), b2 + hstep, voffB);
            PG8_WAIT_V(6); PG8_BAR; PG8_MMA(1, 1, At, B1); PG8_BAR;
            PG8_LDB(B0, 1, 0); PG8_SCHED; PG8_LDA(At, 1, 0); PG8_STAGE(PG8_SA(0, 1), a2 + hstep, voffA);
            PG8_WAIT_L(8); PG8_BAR; PG8_WAIT_L(0); PG8_MMA(0, 0, At, B0); PG8_BAR; PG8_SCHED;
            PG8_LDB(B1, 1, 1); PG8_STAGE(PG8_SB(1, 0), b3, voffB);
            PG8_BAR; PG8_WAIT_L(0); PG8_MMA(0, 1, At, B1); PG8_BAR;
            PG8_LDA(At, 1, 1); PG8_STAGE(PG8_SA(1, 0), a3, voffA);
            PG8_BAR; PG8_WAIT_L(0); PG8_MMA(1, 0, At, B0); PG8_BAR; PG8_SCHED;
            PG8_STAGE(PG8_SB(1, 1), b3 + hstep, voffB);
            PG8_WAIT_V(6); PG8_BAR; PG8_MMA(1, 1, At, B1); PG8_BAR;
            }
        }
        if constexpr (ALIGN_EPI) { if (wr == 0) PG8_BAR; }
        if constexpr (!Epi::AFTER_DRAIN) { E(acc, cur, wr, wc, fr, fq); S.done(cur); }
        if (!has_next) break;
#pragma unroll
        for (int a = 0; a < 2; ++a)
#pragma unroll
            for (int b = 0; b < 2; ++b)
#pragma unroll
                for (int m = 0; m < 4; ++m)
#pragma unroll
                    for (int n = 0; n < 2; ++n) acc[a][b][m][n] = (f32x4){0.f, 0.f, 0.f, 0.f};
        cur = nxt; cA = nA; cB = nB; ++ui;
        if constexpr (ALIGN_EPI) { if (wr == 1) PG8_BAR; }
    }
    PG8_WAIT_V(0);
    if constexpr (!ALIGN_EPI) { if (wr == 0) PG8_BAR; }
    PG8_BAR;
    if constexpr (Epi::AFTER_DRAIN) { E.fused(acc, cur, wr, wc, fr, fq, lds, wid, lane); S.done(cur); }
#undef PG8_SA
#undef PG8_SB
#undef PG8_STAGE
#undef PG8_LDA
#undef PG8_LDB
#undef PG8_MMA
#undef PG8_WAIT_V
#undef PG8_WAIT_L
#undef PG8_BAR
#undef PG8_SCHED
}
}
#define GAS __attribute__((address_space(1)))
#define LAS __attribute__((address_space(3)))
typedef unsigned short bf16;
typedef unsigned v4u __attribute__((ext_vector_type(4)));
typedef float f32x4 __attribute__((ext_vector_type(4)));
typedef short bf16x8 __attribute__((ext_vector_type(8)));
typedef GAS unsigned gu32;
typedef GAS unsigned long long gu64;
#define RLX_AGENT __ATOMIC_RELAXED, __HIP_MEMORY_SCOPE_AGENT
#define LDS_WAIT() asm volatile("s_waitcnt lgkmcnt(0)" ::: "memory")
#define VM_WAIT() asm volatile("s_waitcnt vmcnt(0)" ::: "memory")
__device__ __forceinline__ unsigned long long rt() { return __builtin_amdgcn_s_memrealtime(); }
__device__ __forceinline__ unsigned f2bf(float f) { unsigned u = __builtin_bit_cast(unsigned, f); return (u + 0x7fffu + ((u >> 16) & 1u)) >> 16; }
__device__ __forceinline__ unsigned pk2(float lo, float hi) { return f2bf(lo) | (f2bf(hi) << 16); }

#define XB_TMO      128
#define XB_XCNT(j)  (256  + 64 * (j))
#define XB_XSUB(j)  (1280 + 64 * (j))
#define XB_XGEN(j)  (2304 + 64 * (j))
#define XB_TOP      3328
#define XB_TOPGEN   3392
#define XCD_BAR_WORDS 3456
#define XB_SPIN_CAP (1u << 18)

__device__ __forceinline__ unsigned xb_ld(unsigned* p)              { return __hip_atomic_load(p, __ATOMIC_RELAXED, __HIP_MEMORY_SCOPE_AGENT); }
__device__ __forceinline__ unsigned xb_add(unsigned* p, unsigned v) { return __hip_atomic_fetch_add(p, v, __ATOMIC_RELAXED, __HIP_MEMORY_SCOPE_AGENT); }
__device__ __forceinline__ unsigned xb_xcc_id() { return (unsigned)__builtin_amdgcn_s_getreg((3 << 11) | 20) & 0xFu; }
#define XB_SPIN(cond, bar) do { unsigned _sp = 0; while (cond) { __builtin_amdgcn_s_sleep(1); \
    if ((++_sp & 255u) == 0u) { if (xb_ld(&(bar)[XB_TMO])) break; if (_sp > XB_SPIN_CAP) { atomicAdd(&(bar)[XB_TMO], 1u); break; } } } } while (0)

struct XcdBarrier {
    unsigned* bar; unsigned x;
    volatile LAS unsigned* st;
};

__device__ __forceinline__ XcdBarrier xcd_barrier_post(unsigned* bar, volatile LAS unsigned* st) {
    XcdBarrier b; b.bar = bar; b.x = xb_xcc_id(); b.st = st;
    if (threadIdx.x == 0) (void)xb_add(&bar[XB_XCNT(b.x)], 1u);
    return b;
}
__device__ __forceinline__ void xcd_barrier_complete(unsigned* bar, unsigned x, unsigned& nloc, unsigned& nx) {
    const unsigned G = gridDim.x * gridDim.y * gridDim.z;
    unsigned sum, cnt, mine, sp = 0u;
    for (;;) {
        sum = 0u; cnt = 0u; mine = 0u;
#pragma unroll
        for (unsigned j = 0; j < 16; ++j) { const unsigned c = xb_ld(&bar[XB_XCNT(j)]); sum += c; cnt += (c > 0u) ? 1u : 0u; mine = (j == x) ? c : mine; }
        if (sum == G) break;
        __builtin_amdgcn_s_sleep(1);
        if ((++sp & 255u) == 0u) { if (xb_ld(&bar[XB_TMO])) break; if (sp > XB_SPIN_CAP) { atomicAdd(&bar[XB_TMO], 1u); break; } }
    }
    nloc = mine > 0u ? mine : 1u; nx = cnt > 0u ? cnt : 1u;
}

__device__ __forceinline__ void xcd_barrier(const XcdBarrier& b) {
    asm volatile("s_waitcnt vmcnt(0)" ::: "memory");
    __syncthreads();
    if (threadIdx.x == 0) {
        unsigned* bar = b.bar;
        __builtin_amdgcn_s_waitcnt(0);
        unsigned nloc = b.st[0], nx = b.st[1];
        if (nloc == 0u) { xcd_barrier_complete(bar, b.x, nloc, nx); b.st[0] = nloc; b.st[1] = nx; }
        const unsigned old = xb_add(&bar[XB_XSUB(b.x)], 1u);
        const unsigned gen = old / nloc;
        if (old + 1u == (gen + 1u) * nloc) {
            __builtin_amdgcn_fence(__ATOMIC_RELEASE, "agent");
            asm volatile("s_waitcnt vmcnt(0)" ::: "memory");
            const unsigned og = xb_add(&bar[XB_TOP], 1u);
            const unsigned tg = og / nx;
            if (og + 1u == (tg + 1u) * nx) xb_add(&bar[XB_TOPGEN], 1u);
            else XB_SPIN(xb_ld(&bar[XB_TOPGEN]) == tg, bar);
            __builtin_amdgcn_fence(__ATOMIC_ACQUIRE, "agent");
            xb_add(&bar[XB_XGEN(b.x)], 1u);
            asm volatile("s_waitcnt vmcnt(0)" ::: "memory");
        } else {
            XB_SPIN(xb_ld(&bar[XB_XGEN(b.x)]) == gen, bar);
            __builtin_amdgcn_fence(__ATOMIC_ACQUIRE, "agent");
            asm volatile("s_waitcnt vmcnt(0)" ::: "memory");
        }
    }
    __syncthreads();
}

constexpr int DM = 2048, DFF = 5632, INW = 4352, NLAYER = 4;
constexpr int SEQ = 8192, MP = 2 * SEQ, DSEQ = 64, DB = 32, MS = DB * DSEQ, M = MP + MS;
constexpr int C_P = 0, C_H = 512, C_BG = 1280, C_CG = 2048, C_U = 2816, C_V = 3584;
constexpr float EPS = 1e-6f;
constexpr int NWAVES = 8;
constexpr size_t O_YP = 0, O_YS = (size_t)MP * DM, O_PP = (size_t)M * DM, O_CP = O_PP + (size_t)NLAYER * 2 * 15 * 512, O_PS = O_CP + (size_t)NLAYER * 2 * 2 * 768,
                 O_CS = O_PS + (size_t)NLAYER * DB * 15 * 512, O_VS = O_CS + (size_t)NLAYER * DB * 2 * 768, O_END = O_VS + (size_t)NLAYER * DB * DSEQ * 768;
static_assert(O_END == 45293568, "d_out map");
constexpr size_t WS_CTL = 0, CTL_ZERO_BYTES = 1u << 20;
constexpr size_t SZ_WGU = (size_t)2 * DFF * DM * 2, SZ_WD = (size_t)DM * DFF * 2, SZ_WIN = (size_t)INW * DM * 2, SZ_WOUT = (size_t)DM * DM * 2, SZ_POOLW = (size_t)4 * 128 * 128 * 2, SZ_SGUW = (size_t)6 * 128 * 128 * 2;
constexpr size_t WS_WGU = 1u << 20, WS_WD = WS_WGU + 8 * SZ_WGU, WS_WIN = WS_WD + 8 * SZ_WD, WS_WOUT = WS_WIN + 4 * SZ_WIN, WS_POOLW = WS_WOUT + 4 * SZ_WOUT, WS_SGUW = WS_POOLW + 4 * SZ_POOLW;
constexpr size_t WS_XB = WS_SGUW + 4 * SZ_SGUW, WS_H = WS_XB + (size_t)M * DM * 2, WS_D = WS_H + (size_t)M * DFF * 2, WS_YU = WS_D + (size_t)M * DM * 4;
constexpr size_t WS_SSX = WS_YU + (size_t)M * DM * 2, WS_SSD = WS_SSX + (size_t)M * 4, WS_GS = WS_SSD + (size_t)M * 32 * 4, WS_END = WS_GS + (size_t)M * 16 * 4;
static_assert(WS_END <= 1475633152ull, "d_ws map exceeds the guaranteed workspace");
static_assert(WS_XB % 256 == 0 && WS_H % 256 == 0 && WS_D % 256 == 0 && WS_YU % 256 == 0 && WS_SSX % 256 == 0 && WS_SSD % 256 == 0 && WS_GS % 256 == 0, "alignment");
constexpr int CW_BAR = 4096;
constexpr int RING_BYTES = 131072, MISC_OFF = RING_BYTES, LDS_BYTES = RING_BYTES + 1024;

typedef unsigned u32x2 __attribute__((ext_vector_type(2)));
__device__ __forceinline__ float bf2f(unsigned short b) { return __builtin_bit_cast(float, (unsigned)b << 16); }
__device__ __forceinline__ float wave_sum(float v) {
#pragma unroll
    for (int o = 1; o < 64; o <<= 1) v += __shfl_xor(v, o);
    return v;
}
__device__ __forceinline__ void unpack8(bf16x8 v, float (&f)[8]) {
#pragma unroll
    for (int i = 0; i < 8; ++i) f[i] = bf2f((unsigned short)v[i]);
}
__device__ __forceinline__ void unpack4(u32x2 v, float (&f)[4]) {
    f[0] = __builtin_bit_cast(float, v.x << 16); f[1] = __builtin_bit_cast(float, v.x & 0xffff0000u);
    f[2] = __builtin_bit_cast(float, v.y << 16); f[3] = __builtin_bit_cast(float, v.y & 0xffff0000u);
}

struct EpiGateUp {
    static constexpr bool PERM = true, AFTER_DRAIN = false;
    bf16* H; const float* ssx;
    __device__ __forceinline__ void operator()(const pg8::f32x4 (&acc)[2][2][4][2], const pg8::Unit& u, int wr, int wc, int fr, int fq) const {
        const int row0 = u.pm * 256 + wr * 64 + fr, col0 = u.pn * 128 + wc * 32 + 8 * fq;
        float rs[2][4];
#pragma unroll
        for (int ai = 0; ai < 2; ++ai)
#pragma unroll
            for (int m = 0; m < 4; ++m) rs[ai][m] = ssx[row0 + ai * 128 + m * 16];
#pragma unroll
        for (int ai = 0; ai < 2; ++ai)
#pragma unroll
            for (int m = 0; m < 4; ++m) {
                const int row = row0 + ai * 128 + m * 16;
                const float r = __builtin_amdgcn_rsqf(rs[ai][m] * (1.0f / DM) + EPS);
                float hv[8];
#pragma unroll
                for (int n = 0; n < 2; ++n)
#pragma unroll
                    for (int e = 0; e < 4; ++e) { const float g = acc[ai][0][m][n][e] * r, uu = acc[ai][1][m][n][e] * r;
                        hv[4 * n + e] = g * __builtin_amdgcn_rcpf(1.0f + __expf(-g)) * uu; }
                v4u w; w.x = pg8::cvt_pk_bf16(hv[0], hv[1]); w.y = pg8::cvt_pk_bf16(hv[2], hv[3]); w.z = pg8::cvt_pk_bf16(hv[4], hv[5]); w.w = pg8::cvt_pk_bf16(hv[6], hv[7]);
                *(v4u*)(H + (size_t)row * DFF + col0) = w;
            }
    }
};
struct EpiProj {
    static constexpr bool PERM = true, AFTER_DRAIN = false;
    bf16* P; const float* ssx;
    __device__ __forceinline__ void operator()(const pg8::f32x4 (&acc)[2][2][4][2], const pg8::Unit& u, int wr, int wc, int fr, int fq) const {
        const int row0 = u.pm * 256 + wr * 64 + fr, col0 = u.pn * 256 + wc * 32 + 8 * fq;
        float rs[2][4];
#pragma unroll
        for (int ai = 0; ai < 2; ++ai)
#pragma unroll
            for (int m = 0; m < 4; ++m) rs[ai][m] = ssx[row0 + ai * 128 + m * 16];
#pragma unroll
        for (int ai = 0; ai < 2; ++ai)
#pragma unroll
            for (int m = 0; m < 4; ++m) {
                const int row = row0 + ai * 128 + m * 16;
                const float r = __builtin_amdgcn_rsqf(rs[ai][m] * (1.0f / DM) + EPS);
#pragma unroll
                for (int bj = 0; bj < 2; ++bj) { const pg8::f32x4 v0 = acc[ai][bj][m][0] * r, v1 = acc[ai][bj][m][1] * r;
                    v4u w; w.x = pg8::cvt_pk_bf16(v0[0], v0[1]); w.y = pg8::cvt_pk_bf16(v0[2], v0[3]); w.z = pg8::cvt_pk_bf16(v1[0], v1[1]); w.w = pg8::cvt_pk_bf16(v1[2], v1[3]);
                    *(v4u*)(P + (size_t)row * INW + col0 + bj * 128) = w; }
            }
    }
};
struct EpiF32SS {
    static constexpr bool PERM = false, AFTER_DRAIN = false;
    float* D; float* ssd;
    __device__ __forceinline__ void operator()(const pg8::f32x4 (&acc)[2][2][4][2], const pg8::Unit& u, int wr, int wc, int fr, int fq) const {
        const int row0 = u.pm * 256 + wr * 64 + fr, col0 = u.pn * 256 + wc * 32 + 4 * fq;
#pragma unroll
        for (int ai = 0; ai < 2; ++ai)
#pragma unroll
            for (int m = 0; m < 4; ++m) {
                const int row = row0 + ai * 128 + m * 16; float* rowp = D + (size_t)row * DM + col0; float s = 0.f;
#pragma unroll
                for (int bj = 0; bj < 2; ++bj)
#pragma unroll
                    for (int n = 0; n < 2; ++n) { const pg8::f32x4 v = acc[ai][bj][m][n]; *(pg8::f32x4*)(rowp + bj * 128 + n * 16) = v; s += (v[0] * v[0] + v[1] * v[1]) + (v[2] * v[2] + v[3] * v[3]); }
                s += __shfl_xor(s, 16); s += __shfl_xor(s, 32);
                if (fq == 0) ssd[(size_t)row * 32 + u.pn * 4 + wc] = s;
            }
    }
};

__device__ __forceinline__ void cvt_item(const float* W, int K, int N, const float* gain, bf16* WT, int sh, int add, LAS float* scr, int item, int lane) {
    const int nblk = N >> 5, kb = item / nblk, nb = item - kb * nblk, k0 = kb << 6, n0 = nb << 5;
#pragma unroll 8
    for (int i = 0; i < 32; ++i) { const int kk = 2 * i + (lane >> 5); float v = W[(size_t)(k0 + kk) * N + n0 + (lane & 31)]; if (gain) v *= gain[k0 + kk]; scr[kk * 33 + (lane & 31)] = v; }
    LDS_WAIT(); asm volatile("" ::: "memory");
    const int c = lane & 7;
#pragma unroll
    for (int j = 0; j < 4; ++j) { const int n = (lane >> 3) + 8 * j; const LAS float* s = scr + (8 * c) * 33 + n;
        v4u o; o.x = pk2(s[0 * 33], s[1 * 33]); o.y = pk2(s[2 * 33], s[3 * 33]); o.z = pk2(s[4 * 33], s[5 * 33]); o.w = pk2(s[6 * 33], s[7 * 33]);
        const int nn = n0 + n, orow = ((nn >> 7) << sh) + add + (nn & 127);
        *(v4u*)(WT + (size_t)orow * K + k0 + 8 * c) = o; }
    LDS_WAIT(); asm volatile("" ::: "memory");
}

__device__ __forceinline__ void ew_phase(float* X, bf16* XB, float* SSX, const float* D, const float* SSD, const float* gain, float alpha, int gw, int ngw, int lane) {
    for (int row = gw; row < M; row += ngw) {
        float sd = (lane < 32) ? SSD[(size_t)row * 32 + lane] : 0.f; sd = wave_sum(sd);
        const float sc = __builtin_amdgcn_rsqf(sd * (1.0f / DM) + EPS) * alpha;
        f32x4* xr = (f32x4*)(X + (size_t)row * DM) + lane; const f32x4* dr = (const f32x4*)(D + (size_t)row * DM) + lane; const f32x4* gr = (const f32x4*)gain + lane;
        u32x2* xb = (u32x2*)(XB + (size_t)row * DM) + lane;
        f32x4 xv[8], dv[8];
#pragma unroll
        for (int j = 0; j < 8; ++j) { xv[j] = xr[64 * j]; dv[j] = dr[64 * j]; }
        float ss = 0.f;
#pragma unroll
        for (int j = 0; j < 8; ++j) { const f32x4 g = gr[64 * j]; const f32x4 x = xv[j] + dv[j] * g * sc; xr[64 * j] = x;
            u32x2 w; w.x = pk2(x[0], x[1]); w.y = pk2(x[2], x[3]); xb[64 * j] = w; ss += (x[0] * x[0] + x[1] * x[1]) + (x[2] * x[2] + x[3] * x[3]); }
        ss = wave_sum(ss); if (lane == 0) SSX[row] = ss;
    }
}

__device__ __forceinline__ void pool_unit(int l, int tb, int g, const bf16* PROJ, const float* state_pool, const bf16* POOLW, bf16* YU, float* GS, int lane) {
    const int r0 = tb * 16, tr = lane & 15, kq = lane >> 4;
    const bool samp = r0 >= MP;
    int seq0, tloc, sb = 0;
    if (!samp) { seq0 = r0 & ~(SEQ - 1); tloc = (r0 & (SEQ - 1)) + tr; } else { sb = (r0 - MP) >> 6; seq0 = MP + (sb << 6); tloc = ((r0 - MP) & 63) + tr; }
    const int w = 2 << g;
    const int cnt = samp ? w : ((tloc + 1) < w ? (tloc + 1) : w);
    const float invc = 1.0f / (float)cnt;
    bf16x8 dfr[4];
#pragma unroll
    for (int kt = 0; kt < 4; ++kt) {
        const int c = g * 128 + 32 * kt + 8 * kq;
        float p0[8], s[8];
        { const bf16x8 v = *(const bf16x8*)(PROJ + (size_t)(seq0 + tloc) * INW + C_P + c); unpack8(v, p0); }
#pragma unroll
        for (int i = 0; i < 8; ++i) s[i] = p0[i];
        for (int jj = 1; jj < w; ++jj) {
            const int tt = tloc - jj; float v[8];
            if (tt >= 0) { const bf16x8 q = *(const bf16x8*)(PROJ + (size_t)(seq0 + tt) * INW + C_P + c); unpack8(q, v); }
            else if (samp) { const float* hp = state_pool + ((size_t)(l * DB + sb) * 15 + 15 + tt) * 512 + c; const f32x4 a = *(const f32x4*)hp, b = *(const f32x4*)(hp + 4);
                v[0] = a[0]; v[1] = a[1]; v[2] = a[2]; v[3] = a[3]; v[4] = b[0]; v[5] = b[1]; v[6] = b[2]; v[7] = b[3]; }
            else {
#pragma unroll
                for (int i = 0; i < 8; ++i) v[i] = 0.f; }
#pragma unroll
            for (int i = 0; i < 8; ++i) s[i] += v[i];
        }
        bf16x8 d;
#pragma unroll
        for (int i = 0; i < 8; ++i) d[i] = (short)f2bf(s[i] * invc - p0[i]);
        dfr[kt] = d;
    }
    f32x4 acc[8];
#pragma unroll
    for (int dt = 0; dt < 8; ++dt) acc[dt] = (f32x4){0.f, 0.f, 0.f, 0.f};
    const bf16* Wg = POOLW + (size_t)(l * 4 + g) * 128 * 128;
#pragma unroll
    for (int dt = 0; dt < 8; ++dt)
#pragma unroll
        for (int kt = 0; kt < 4; ++kt) { const bf16x8 wf = *(const bf16x8*)(Wg + (size_t)(16 * dt + tr) * 128 + 32 * kt + 8 * kq);
            acc[dt] = __builtin_amdgcn_mfma_f32_16x16x32_bf16(wf, dfr[kt], acc[dt], 0, 0, 0); }
    float ss = 0.f; const int row = r0 + tr;
#pragma unroll
    for (int dt = 0; dt < 8; ++dt) { const f32x4 a = acc[dt]; u32x2 o; o.x = pk2(a[0], a[1]); o.y = pk2(a[2], a[3]);
        *(u32x2*)(YU + (size_t)row * DM + g * 128 + 16 * dt + 4 * kq) = o; ss += (a[0] * a[0] + a[1] * a[1]) + (a[2] * a[2] + a[3] * a[3]); }
    ss += __shfl_xor(ss, 16); ss += __shfl_xor(ss, 32);
    if (kq == 0) GS[(size_t)row * 16 + g] = ss;
}
__device__ __forceinline__ void conv_z(int l, int seq0, int tt, bool samp, int sb, int c, const bf16* PROJ, const float* state_conv, float (&z)[4]) {
    if (tt >= 0) { float h[4], cg[4]; unpack4(*(const u32x2*)(PROJ + (size_t)(seq0 + tt) * INW + C_H + c), h); unpack4(*(const u32x2*)(PROJ + (size_t)(seq0 + tt) * INW + C_CG + c), cg);
#pragma unroll
        for (int i = 0; i < 4; ++i) z[i] = cg[i] * h[i]; }
    else if (samp) { const f32x4 a = *(const f32x4*)(state_conv + ((size_t)(l * DB + sb) * 2 + 2 + tt) * 768 + c); z[0] = a[0]; z[1] = a[1]; z[2] = a[2]; z[3] = a[3]; }
    else { z[0] = 0.f; z[1] = 0.f; z[2] = 0.f; z[3] = 0.f; }
}
__device__ __forceinline__ void conv_row(int l, int row, const bf16* PROJ, const float* state_conv, const float* conv_w, bf16* YU, float* GS, int lane) {
    const bool samp = row >= MP; int seq0, tloc, sb = 0;
    if (!samp) { seq0 = row & ~(SEQ - 1); tloc = row & (SEQ - 1); } else { sb = (row - MP) >> 6; seq0 = MP + (sb << 6); tloc = (row - MP) & 63; }
    float ss = 0.f;
#pragma unroll
    for (int j = 0; j < 3; ++j) {
        const int c = 256 * j + 4 * lane;
        float z0[4], z1[4], z2[4], bg[4];
        conv_z(l, seq0, tloc, samp, sb, c, PROJ, state_conv, z0); conv_z(l, seq0, tloc - 1, samp, sb, c, PROJ, state_conv, z1); conv_z(l, seq0, tloc - 2, samp, sb, c, PROJ, state_conv, z2);
        unpack4(*(const u32x2*)(PROJ + (size_t)row * INW + C_BG + c), bg);
        const f32x4 w0 = *(const f32x4*)(conv_w + (size_t)(l * 3 + 0) * 768 + c), w1 = *(const f32x4*)(conv_w + (size_t)(l * 3 + 1) * 768 + c), w2 = *(const f32x4*)(conv_w + (size_t)(l * 3 + 2) * 768 + c);
        float y[4];
#pragma unroll
        for (int i = 0; i < 4; ++i) { y[i] = bg[i] * (z2[i] * w0[i] + z1[i] * w1[i] + z0[i] * w2[i]); ss += y[i] * y[i]; }
        u32x2 o; o.x = pk2(y[0], y[1]); o.y = pk2(y[2], y[3]);
        *(u32x2*)(YU + (size_t)row * DM + 512 + c) = o;
    }
    ss = wave_sum(ss); if (lane == 0) GS[(size_t)row * 16 + 4] = ss;
}
__device__ __forceinline__ void sgu_unit(int l, int tb, int h, const bf16* PROJ, const bf16* SGUW, const float* sgu_b, bf16* YU, float* GS, int lane) {
    const int r0 = tb * 16, tr = lane & 15, kq = lane >> 4;
    const bool samp = r0 >= MP;
    const int chunk0 = samp ? (MP + ((r0 - MP) & ~63)) : (r0 & ~127), s0 = r0 - chunk0;
    const int nk = (s0 + 47) >> 5;
    f32x4 acc[8];
#pragma unroll
    for (int ct = 0; ct < 8; ++ct) acc[ct] = (f32x4){0.f, 0.f, 0.f, 0.f};
    const bf16* Wh = SGUW + (size_t)(l * 6 + h) * 128 * 128;
    for (int kt = 0; kt < nk; ++kt) {
        const bf16x8 wf = *(const bf16x8*)(Wh + (size_t)(s0 + tr) * 128 + 32 * kt + 8 * kq);
        const bf16* vp = PROJ + (size_t)(chunk0 + 32 * kt + 8 * kq) * INW + C_V + h * 128 + tr;
#pragma unroll
        for (int ct = 0; ct < 8; ++ct) { bf16x8 vf;
#pragma unroll
            for (int j = 0; j < 8; ++j) vf[j] = (short)vp[(size_t)j * INW + 16 * ct];
            acc[ct] = __builtin_amdgcn_mfma_f32_16x16x32_bf16(vf, wf, acc[ct], 0, 0, 0); }
    }
    const int row = r0 + tr; const float bias = sgu_b[(size_t)(l * 6 + h) * 128 + s0 + tr]; float ss = 0.f;
#pragma unroll
    for (int ct = 0; ct < 8; ++ct) { const int c = h * 128 + 16 * ct + 4 * kq; float uu[4]; unpack4(*(const u32x2*)(PROJ + (size_t)row * INW + C_U + c), uu);
        const f32x4 a = acc[ct]; float y[4];
#pragma unroll
        for (int i = 0; i < 4; ++i) { y[i] = uu[i] * (a[i] + bias); ss += y[i] * y[i]; }
        u32x2 o; o.x = pk2(y[0], y[1]); o.y = pk2(y[2], y[3]);
        *(u32x2*)(YU + (size_t)row * DM + 1280 + c) = o; }
    ss += __shfl_xor(ss, 16); ss += __shfl_xor(ss, 32);
    if (kq == 0) GS[(size_t)row * 16 + 5 + h] = ss;
}
__device__ __forceinline__ void norm_row(int row, bf16* YU, const float* GS, int lane) {
    float gsv = (lane < 16) ? GS[(size_t)row * 16 + lane] : 0.f;
    float sa = (lane < 4) ? gsv : 0.f, sb = (lane == 4) ? gsv : 0.f, sc = (lane >= 5 && lane < 11) ? gsv : 0.f;
    sa = wave_sum(sa); sb = wave_sum(sb); sc = wave_sum(sc);
    const float ra = __builtin_amdgcn_rsqf(sa * (1.0f / 512.0f) + EPS), rb = __builtin_amdgcn_rsqf(sb * (1.0f / 768.0f) + EPS), rc = __builtin_amdgcn_rsqf(sc * (1.0f / 768.0f) + EPS);
    v4u* p = (v4u*)(YU + (size_t)row * DM) + lane;
#pragma unroll
    for (int j = 0; j < 4; ++j) { const int col = 8 * (lane + 64 * j); const float r = col < 512 ? ra : (col < 1280 ? rb : rc);
        const v4u v = p[64 * j]; v4u o;
        o.x = pk2(__builtin_bit_cast(float, v.x << 16) * r, __builtin_bit_cast(float, v.x & 0xffff0000u) * r); o.y = pk2(__builtin_bit_cast(float, v.y << 16) * r, __builtin_bit_cast(float, v.y & 0xffff0000u) * r);
        o.z = pk2(__builtin_bit_cast(float, v.z << 16) * r, __builtin_bit_cast(float, v.z & 0xffff0000u) * r); o.w = pk2(__builtin_bit_cast(float, v.w << 16) * r, __builtin_bit_cast(float, v.w & 0xffff0000u) * r);
        p[64 * j] = o; }
}

struct Args { const float* in[19]; float* out; unsigned char* ws; int step_lo, step_hi, use_bar, pad; };
constexpr int N_STEPS = 1 + 8 * 8;
#define PHASE_ENV \
    int z_ = 0; asm volatile("" : "+s"(z_)); \
    const int lane = (int)__builtin_amdgcn_mbcnt_hi(~0u, __builtin_amdgcn_mbcnt_lo(~0u, (unsigned)z_)); \
    const int wave = __builtin_amdgcn_readfirstlane(wave0 + z_); const int tid = wave * 64 + lane; \
    const int G = (int)gridDim.x, bx = (int)blockIdx.x + z_; \
    const int vcu = (G % 8 == 0) ? (bx % 8) * (G / 8) + bx / 8 : bx; \
    const int gw = vcu * NWAVES + wave, ngw = G * NWAVES; \
    unsigned char* ws = args.ws + z_; float* out = args.out + z_; float* X = out; \
    bf16* XB = (bf16*)(ws + WS_XB); bf16* HB = (bf16*)(ws + WS_H); bf16* PROJ = HB; float* DBUF = (float*)(ws + WS_D); bf16* YU = (bf16*)(ws + WS_YU); \
    float* SSX = (float*)(ws + WS_SSX); float* SSD = (float*)(ws + WS_SSD); float* GS = (float*)(ws + WS_GS); \
    (void)lane; (void)tid; (void)gw; (void)ngw; (void)X; (void)XB; (void)HB; (void)PROJ; (void)DBUF; (void)YU; (void)SSX; (void)SSD; (void)GS; (void)bx;

__global__ void __launch_bounds__(NWAVES * 64, 2) fwd(Args args) {
    extern __shared__ __attribute__((aligned(16))) unsigned char lds_raw[];
    LAS unsigned char* lds = (LAS unsigned char*)lds_raw;
    volatile LAS unsigned* MISC = (volatile LAS unsigned*)(lds + MISC_OFF);
    const int wave0 = __builtin_amdgcn_readfirstlane((int)threadIdx.x >> 6);
    for (int u = threadIdx.x; u < (LDS_BYTES - MISC_OFF) / 4; u += NWAVES * 64) MISC[u] = 0u;
    __syncthreads();
    XcdBarrier bar; bar.bar = (unsigned*)(args.ws + WS_CTL) + CW_BAR; bar.x = 0; bar.st = nullptr;
    if (args.use_bar) bar = xcd_barrier_post((unsigned*)(args.ws + WS_CTL) + CW_BAR, MISC + 8);
#define GRID_BAR() do { if (args.use_bar) xcd_barrier(bar); } while (0)
    const int lo = args.step_lo, hi = args.step_hi;
#define IN(k) (lo <= (k) && (k) < hi)

    if (IN(0)) {
        PHASE_ENV
        const float* norm_gains = args.in[17];
        bf16* WGU = (bf16*)(ws + WS_WGU); bf16* WD = (bf16*)(ws + WS_WD); bf16* WIN = (bf16*)(ws + WS_WIN); bf16* WOUT = (bf16*)(ws + WS_WOUT); bf16* POOLW = (bf16*)(ws + WS_POOLW); bf16* SGUW = (bf16*)(ws + WS_SGUW);
        LAS float* scr = (LAS float*)(lds + wave * 16384);
        constexpr int I_BIG = (DM / 64) * (DFF / 32), I_IN = (DM / 64) * (INW / 32), I_OUT = (DM / 64) * (DM / 32), I_LAYER = 6 * I_BIG + I_IN + I_OUT;
        static_assert(I_BIG == (DFF / 64) * (DM / 32), "gate/up and down item counts match");
        for (int it = gw; it < NLAYER * I_LAYER; it += ngw) {
            const int l = it / I_LAYER; int r = it - l * I_LAYER;
            const float* W; const float* gain; bf16* WT; int K, N, sh = 7, add = 0;
            if (r < 4 * I_BIG) { const int j = r / I_BIG; r -= j * I_BIG; const int f = j >> 1, up = j & 1;
                W = args.in[11 + 3 * f + up] + (size_t)l * DM * DFF; gain = norm_gains + (size_t)(l * 6 + 4 * f) * DM; WT = WGU + (size_t)(2 * l + f) * (2 * DFF * DM); K = DM; N = DFF; sh = 8; add = 128 * up; }
            else if (r < 6 * I_BIG) { r -= 4 * I_BIG; const int f = r / I_BIG; r -= f * I_BIG;
                W = args.in[13 + 3 * f] + (size_t)l * DFF * DM; gain = nullptr; WT = WD + (size_t)(2 * l + f) * (DM * DFF); K = DFF; N = DM; }
            else if (r < 6 * I_BIG + I_IN) { r -= 6 * I_BIG; W = args.in[4] + (size_t)l * DM * INW; gain = norm_gains + (size_t)(l * 6 + 2) * DM; WT = WIN + (size_t)l * (INW * DM); K = DM; N = INW; }
            else { r -= 6 * I_BIG + I_IN; W = args.in[5] + (size_t)l * DM * DM; gain = args.in[18] + (size_t)l * DM; WT = WOUT + (size_t)l * (DM * DM); K = DM; N = DM; }
            cvt_item(W, K, N, gain, WT, sh, add, scr, r, lane);
        }
        const int gt = vcu * (NWAVES * 64) + tid, ngt = G * NWAVES * 64;
        const float* pool_w = args.in[6]; const float* pool_scale = args.in[7]; const float* sgu_w = args.in[9];
        for (int o = gt; o < NLAYER * 4 * 128 * 128; o += ngt) {
            const int c = o & 127, d = (o >> 7) & 127, lg = o >> 14; POOLW[o] = (bf16)f2bf(pool_w[((size_t)lg * 128 + c) * 128 + d] * pool_scale[(size_t)lg * 128 + d]); }
        for (int o = gt; o < NLAYER * 6 * 128 * 128; o += ngt) {
            const int t = o & 127, sr = (o >> 7) & 127; SGUW[o] = (t <= sr) ? (bf16)f2bf(sgu_w[o]) : (bf16)0; }
        const float* x_prompt = args.in[0]; const float* x_sample = args.in[1];
        for (int row = gw; row < M; row += ngw) {
            const f32x4* src = (const f32x4*)(row < MP ? x_prompt + (size_t)row * DM : x_sample + (size_t)(row - MP) * DM) + lane;
            f32x4* xr = (f32x4*)(X + (size_t)row * DM) + lane; u32x2* xb = (u32x2*)(XB + (size_t)row * DM) + lane; float ss = 0.f;
#pragma unroll
            for (int j = 0; j < 8; ++j) { const f32x4 x = src[64 * j]; xr[64 * j] = x; u32x2 w; w.x = pk2(x[0], x[1]); w.y = pk2(x[2], x[3]); xb[64 * j] = w;
                ss += (x[0] * x[0] + x[1] * x[1]) + (x[2] * x[2] + x[3] * x[3]); }
            ss = wave_sum(ss); if (lane == 0) SSX[row] = ss;
        }
        GRID_BAR();
    }

    for (int s = 0; s < 8; ++s) {
        const int l = s >> 1, f = s & 1, base = 1 + s * 8;
        if (IN(base + 0)) {
            PHASE_ENV
            pg8::Gemm g{XB, (bf16*)(ws + WS_WGU) + (size_t)s * (2 * DFF * DM), M, 2 * DFF, DM}; pg8::StaticOrder S; S.init(M, 2 * DFF, G, bx);
            EpiGateUp E{HB, SSX};
            pg8::gemm_phase<EpiGateUp, pg8::StaticOrder, true, true>(lds, g, S, E, tid);
            GRID_BAR();
        }
        if (IN(base + 1)) {
            PHASE_ENV
            pg8::Gemm g{HB, (bf16*)(ws + WS_WD) + (size_t)s * (DM * DFF), M, DM, DFF}; pg8::StaticOrder S; S.init(M, DM, G, bx);
            EpiF32SS E{DBUF, SSD};
            pg8::gemm_phase<EpiF32SS, pg8::StaticOrder, true, true>(lds, g, S, E, tid);
            GRID_BAR();
        }
        if (IN(base + 2)) { PHASE_ENV ew_phase(X, XB, SSX, DBUF, SSD, args.in[17] + (size_t)(l * 6 + (f ? 5 : 1)) * DM, 0.5f, gw, ngw, lane); GRID_BAR(); }
        if (f == 0) {
            if (IN(base + 3)) {
                PHASE_ENV
                pg8::Gemm g{XB, (bf16*)(ws + WS_WIN) + (size_t)l * (INW * DM), M, INW, DM}; pg8::StaticOrder S; S.init(M, INW, G, bx);
                EpiProj E{PROJ, SSX};
                pg8::gemm_phase<EpiProj, pg8::StaticOrder, true, true>(lds, g, S, E, tid);
                GRID_BAR();
            }
            if (IN(base + 4)) {
                PHASE_ENV
                const float* state_pool = args.in[2]; const float* state_conv = args.in[3]; const float* conv_w = args.in[8]; const float* sgu_b = args.in[10];
                const bf16* POOLW = (const bf16*)(ws + WS_POOLW); const bf16* SGUW = (const bf16*)(ws + WS_SGUW);
                for (int u = gw; u < (M / 16) * 4; u += ngw) pool_unit(l, u >> 2, u & 3, PROJ, state_pool, POOLW, YU, GS, lane);
                for (int row = gw; row < M; row += ngw) conv_row(l, row, PROJ, state_conv, conv_w, YU, GS, lane);
                for (int u = gw; u < (M / 16) * 6; u += ngw) { const int tb = u / 6; sgu_unit(l, tb, u - tb * 6, PROJ, SGUW, sgu_b, YU, GS, lane); }
                const int gt = vcu * (NWAVES * 64) + tid, ngt = G * NWAVES * 64;
                for (int o = gt; o < MS * 768; o += ngt) { const int r = o / 768, c = o - r * 768; out[O_VS + (size_t)l * MS * 768 + o] = bf2f(PROJ[(size_t)(MP + r) * INW + C_V + c]); }
                for (int o = gt; o < (2 + DB) * 15 * 512; o += ngt) { const int c = o & 511, ri = o >> 9, b = ri / 15, i = ri - b * 15;
                    if (b < 2) out[O_PP + ((size_t)(l * 2 + b) * 15 + i) * 512 + c] = bf2f(PROJ[(size_t)(b * SEQ + SEQ - 15 + i) * INW + C_P + c]);
                    else out[O_PS + ((size_t)(l * DB + (b - 2)) * 15 + i) * 512 + c] = bf2f(PROJ[(size_t)(MP + (b - 2) * DSEQ + DSEQ - 15 + i) * INW + C_P + c]); }
                for (int o = gt; o < (2 + DB) * 2 * 768; o += ngt) { const int c = o % 768, ri = o / 768, b = ri >> 1, i = ri & 1;
                    const size_t row = b < 2 ? (size_t)(b * SEQ + SEQ - 2 + i) : (size_t)(MP + (b - 2) * DSEQ + DSEQ - 2 + i);
                    const float zz = bf2f(PROJ[row * INW + C_CG + c]) * bf2f(PROJ[row * INW + C_H + c]);
                    if (b < 2) out[O_CP + ((size_t)(l * 2 + b) * 2 + i) * 768 + c] = zz; else out[O_CS + ((size_t)(l * DB + (b - 2)) * 2 + i) * 768 + c] = zz; }
                GRID_BAR();
            }
            if (IN(base + 5)) { PHASE_ENV for (int row = gw; row < M; row += ngw) norm_row(row, YU, GS, lane); GRID_BAR(); }
            if (IN(base + 6)) {
                PHASE_ENV
                pg8::Gemm g{YU, (bf16*)(ws + WS_WOUT) + (size_t)l * (DM * DM), M, DM, DM}; pg8::StaticOrder S; S.init(M, DM, G, bx);
                EpiF32SS E{DBUF, SSD};
                pg8::gemm_phase<EpiF32SS, pg8::StaticOrder, true, true>(lds, g, S, E, tid);
                GRID_BAR();
            }
            if (IN(base + 7)) { PHASE_ENV ew_phase(X, XB, SSX, DBUF, SSD, args.in[17] + (size_t)(l * 6 + 3) * DM, 1.0f, gw, ngw, lane); GRID_BAR(); }
        }
    }
#undef IN
#undef GRID_BAR
}

#ifndef MK_ONE_LAUNCH
#define MK_ONE_LAUNCH 0
#endif
extern "C" void kernel_launch(void* const* d_in, const int* in_sizes, int n_in, void* d_out, int out_size, void* d_ws, size_t ws_size, hipStream_t stream) {
    static int grid = 0;
    if (grid == 0) {
        if (n_in != 19 || out_size != (int)O_END || ws_size < WS_END) { fprintf(stderr, "kernel_launch: unexpected shapes: n_in %d out %d ws %zu (need %zu); nothing launched\n", n_in, out_size, ws_size, (size_t)WS_END); grid = -1; return; }
        int dev = 0, cus = 0, per_cu = 0;
        if (hipGetDevice(&dev) != hipSuccess || hipDeviceGetAttribute(&cus, hipDeviceAttributeMultiprocessorCount, dev) != hipSuccess) { fprintf(stderr, "kernel_launch: device query failed\n"); grid = -1; return; }
        if (hipFuncSetAttribute((const void*)fwd, hipFuncAttributeMaxDynamicSharedMemorySize, LDS_BYTES) != hipSuccess) { fprintf(stderr, "kernel_launch: hipFuncSetAttribute failed\n"); grid = -1; return; }
        if (hipOccupancyMaxActiveBlocksPerMultiprocessor(&per_cu, (const void*)fwd, NWAVES * 64, LDS_BYTES) != hipSuccess || per_cu < 1) { fprintf(stderr, "kernel_launch: occupancy query reports %d workgroups per CU\n", per_cu); }
        (void)hipGetLastError();
        grid = cus;
    }
    if (grid < 0) return;
    if (hipMemsetAsync((char*)d_ws + WS_CTL, 0, CTL_ZERO_BYTES, stream) != hipSuccess) { fprintf(stderr, "kernel_launch: memset failed\n"); return; }
    Args a{};
    for (int i = 0; i < 19; ++i) a.in[i] = (const float*)d_in[i];
    a.out = (float*)d_out; a.ws = (unsigned char*)d_ws;
#if MK_ONE_LAUNCH
    a.step_lo = 0; a.step_hi = N_STEPS; a.use_bar = 1;
    hipLaunchKernelGGL(fwd, dim3(grid), dim3(NWAVES * 64), LDS_BYTES, stream, a);
#else
    for (int st = 0; st < N_STEPS; ++st) {
        if (st > 0) { const int s = (st - 1) >> 3, p = (st - 1) & 7; if ((s & 1) && p >= 3) continue; }
        a.step_lo = st; a.step_hi = st + 1; a.use_bar = 0;
        hipLaunchKernelGGL(fwd, dim3(grid), dim3(NWAVES * 64), LDS_BYTES, stream, a);
    }
#endif
    const hipError_t le = hipPeekAtLastError();
    if (le != hipSuccess) fprintf(stderr, "kernel_launch: launch failed: %s\n", hipGetErrorName(le));
}
```

```cpp
#include <hip/hip_runtime.h>
#include <cstdio>
#include <cstdint>
namespace pg8 {
#define PG8_LAS __attribute__((address_space(3)))
typedef unsigned short bf16_t;
typedef short bf16x8 __attribute__((ext_vector_type(8)));
typedef float f32x4 __attribute__((ext_vector_type(4)));
typedef unsigned u32x4 __attribute__((ext_vector_type(4)));
constexpr int BM = 256, BK = 64, HALF = 128, HTB = HALF * BK * 2  , STAGE_BYTES = 8 * HTB, NXCD = 8, WGM = 8;

__host__ __device__ __forceinline__ int lds_byte(int r, int c) { const int st = (r >> 4) * 2 + (c >> 5), rr = r & 15, cc = c & 31, ob = rr * 64 + cc * 2; return st * 1024 + (ob ^ (((ob >> 9) & 1) << 5)); }
__host__ __device__ __forceinline__ void stage_rc(int b, int& R, int& C) { const int st = b / 1024, sb = b % 1024, swz = sb ^ (((sb >> 9) & 1) << 5); R = (st >> 1) * 16 + swz / 64; C = (st & 1) * 32 + (swz % 64) / 2; }
__host__ __device__ __forceinline__ int perm32(int rho) { const int n = rho >> 4, i = rho & 15; return 8 * (i >> 2) + 4 * n + (i & 3); }

struct Unit { int pm, pn, kb, nt, slab; };
struct Gemm { const bf16_t* A; const bf16_t* Bt; int M, N, K; };

struct StaticOrder {
    int nM, nN, nwg, G, c, ntK, pn0;
    __host__ __device__ void init(int M, int N, int K, int G_, int c_, int pn0_ = 0) { nM = M / BM; nN = N / BM; nwg = nM * nN; G = G_; c = c_; ntK = K / BK; pn0 = pn0_; }
    __host__ __device__ bool next(int i, Unit& u) const {
        const long L = (long)i * G + c; if (L >= nwg) return false;
        int wgid = (int)L; { const int q = nwg / NXCD, r = nwg % NXCD, xcd = wgid % NXCD, off = wgid / NXCD; wgid = (xcd < r ? xcd * (q + 1) : r * (q + 1) + (xcd - r) * q) + off; }
        const int nig = WGM * nN, gid = wgid / nig, fm = gid * WGM, gsz = (nM - fm) < WGM ? (nM - fm) : WGM;
        u.pm = fm + ((wgid % nig) % gsz); u.pn = pn0 + (wgid % nig) / gsz; u.kb = 0; u.nt = ntK; u.slab = 0; return true;
    }
    __device__ __forceinline__ void a_ready(const Unit&) const {}
    __device__ __forceinline__ void done(const Unit&) const {}
};
struct SplitOrder {
    int c, ntK;
    __host__ __device__ void init(int K, int c_) { c = c_; ntK = K / BK; }
    __host__ __device__ bool next(int i, Unit& u) const {
        if (i < 2) { const int L = i * 256 + c, wgid = (L & 7) * 64 + (L >> 3), w64 = wgid & 63;
            u.pm = (wgid >> 6) * 8 + (w64 & 7); u.pn = w64 >> 3; u.kb = 0; u.nt = ntK; u.slab = 0; return true; }
        if (i == 2) { const int j = c >> 3, q = j >> 3; u.pm = 64 + (c & 7); u.pn = j & 7; u.nt = ntK >> 2; u.kb = q * u.nt; u.slab = 1 + q; return true; }
        return false;
    }
    __device__ __forceinline__ void a_ready(const Unit&) const {}
    __device__ __forceinline__ void done(const Unit&) const {}
};

__device__ __forceinline__ unsigned cvt_pk_bf16(float lo, float hi) { unsigned r; asm volatile("v_cvt_pk_bf16_f32 %0, %1, %2" : "=v"(r) : "v"(lo), "v"(hi)); return r; }
template <class Epi, class Sched, bool ALIGN_EPI = false, bool SP2 = false, bool SWAP = false>
__device__ __forceinline__ void gemm_phase(PG8_LAS unsigned char* lds, const Gemm g, const Sched& S, const Epi& E, const int tid) {
    const int wid = __builtin_amdgcn_readfirstlane(tid >> 6), lane = tid & 63, wr = wid >> 2, wc = wid & 3, fr = lane & 15, fq = lane >> 4;
    const int K = g.K;
    unsigned voffA[2], voffB[2];
#pragma unroll
    for (int i = 0; i < 2; ++i) { int R, C; stage_rc(tid * 16 + i * 8192, R, C); const int Rb = Epi::PERM ? ((R & ~31) + perm32(R & 31)) : R;
        voffA[i] = (unsigned)(R * K + C) * 2u; voffB[i] = (unsigned)(Rb * K + C) * 2u; }
    const size_t kstep = (size_t)(BK * 2);
    const size_t hstep = (size_t)HALF * K * 2;
    const size_t tstep = 2 * hstep;
    const unsigned ldsw = (unsigned)wid * 1024u;
    const int aoff = lds_byte(wr * 64 + fr, fq * 8), boff = lds_byte(wc * 32 + fr, fq * 8);
#define PG8_SA(b, h) (((b) * 2 + (h)) * HTB)
#define PG8_SB(b, h) ((4 + (b) * 2 + (h)) * HTB)
#define PG8_STAGE(bufoff, gbase, voff) do { _Pragma("unroll") for (int _i = 0; _i < 2; ++_i) \
        __builtin_amdgcn_global_load_lds((const unsigned*)((const char*)(gbase) + (voff)[_i]), (PG8_LAS unsigned*)(lds + (bufoff) + ldsw + _i * 8192), 16, 0, 0); } while (0)
#define PG8_LDA(dst, b, h) do { _Pragma("unroll") for (int m = 0; m < 4; ++m) _Pragma("unroll") for (int k = 0; k < 2; ++k) dst[m][k] = *(const PG8_LAS bf16x8*)(lds + PG8_SA(b, h) + aoff + m * 2048 + k * 1024); } while (0)
#define PG8_LDB(dst, b, h) do { _Pragma("unroll") for (int n = 0; n < 2; ++n) _Pragma("unroll") for (int k = 0; k < 2; ++k) dst[n][k] = *(const PG8_LAS bf16x8*)(lds + PG8_SB(b, h) + boff + n * 2048 + k * 1024); } while (0)
#define PG8_MMA(ai, bj, At, Bt) do { __builtin_amdgcn_s_setprio(1); _Pragma("unroll") for (int m = 0; m < 4; ++m) _Pragma("unroll") for (int n = 0; n < 2; ++n) _Pragma("unroll") for (int k = 0; k < 2; ++k) \
        acc[ai][bj][m][n] = SWAP ? __builtin_amdgcn_mfma_f32_16x16x32_bf16(At[m][k], Bt[n][k], acc[ai][bj][m][n], 0, 0, 0) : __builtin_amdgcn_mfma_f32_16x16x32_bf16(Bt[n][k], At[m][k], acc[ai][bj][m][n], 0, 0, 0); __builtin_amdgcn_s_setprio(0); } while (0)
#define PG8_MMA2(ai, bj, At, Bt, ai2, bj2, At2, Bt2) do { __builtin_amdgcn_s_setprio(1); _Pragma("unroll") for (int m = 0; m < 4; ++m) _Pragma("unroll") for (int n = 0; n < 2; ++n) _Pragma("unroll") for (int k = 0; k < 2; ++k) \
        acc[ai][bj][m][n] = SWAP ? __builtin_amdgcn_mfma_f32_16x16x32_bf16(At[m][k], Bt[n][k], acc[ai][bj][m][n], 0, 0, 0) : __builtin_amdgcn_mfma_f32_16x16x32_bf16(Bt[n][k], At[m][k], acc[ai][bj][m][n], 0, 0, 0); \
        _Pragma("unroll") for (int m = 0; m < 4; ++m) _Pragma("unroll") for (int n = 0; n < 2; ++n) _Pragma("unroll") for (int k = 0; k < 2; ++k) \
        acc[ai2][bj2][m][n] = SWAP ? __builtin_amdgcn_mfma_f32_16x16x32_bf16(At2[m][k], Bt2[n][k], acc[ai2][bj2][m][n], 0, 0, 0) : __builtin_amdgcn_mfma_f32_16x16x32_bf16(Bt2[n][k], At2[m][k], acc[ai2][bj2][m][n], 0, 0, 0); __builtin_amdgcn_s_setprio(0); } while (0)
#define PG8_WAIT_V(n) asm volatile("s_waitcnt vmcnt(" #n ")" ::: "memory")
#define PG8_WAIT_L(n) asm volatile("s_waitcnt lgkmcnt(" #n ")" ::: "memory")
#define PG8_BAR __builtin_amdgcn_s_barrier()
#define PG8_SCHED __builtin_amdgcn_sched_barrier(0)
    Unit cur, nxt; int ui = 0;
    if (!S.next(0, cur)) return;
    f32x4 acc[2][2][4][2];
#pragma unroll
    for (int a = 0; a < 2; ++a)
#pragma unroll
        for (int b = 0; b < 2; ++b)
#pragma unroll
            for (int m = 0; m < 4; ++m)
#pragma unroll
                for (int n = 0; n < 2; ++n) acc[a][b][m][n] = (f32x4){0.f, 0.f, 0.f, 0.f};
    bf16x8 At[4][2], B0[2][2], B1[2][2];
    const char* cA = (const char*)g.A + (size_t)cur.pm * tstep + (size_t)cur.kb * kstep; const char* cB = (const char*)g.Bt + (size_t)cur.pn * tstep + (size_t)cur.kb * kstep;
    S.a_ready(cur);
    if constexpr (SP2) {
        PG8_STAGE(PG8_SB(0, 0), cB, voffB); PG8_STAGE(PG8_SB(0, 1), cB + hstep, voffB); PG8_STAGE(PG8_SA(0, 0), cA, voffA); PG8_STAGE(PG8_SA(0, 1), cA + hstep, voffA);
        if (wr == 1) PG8_BAR;
        PG8_WAIT_V(2); PG8_BAR;
        PG8_STAGE(PG8_SB(1, 0), cB + kstep, voffB); PG8_STAGE(PG8_SA(1, 0), cA + kstep, voffA); PG8_STAGE(PG8_SB(1, 1), cB + hstep + kstep, voffB);
        PG8_WAIT_V(6); PG8_BAR;
    } else {
        PG8_STAGE(PG8_SB(0, 0), cB, voffB); PG8_STAGE(PG8_SA(0, 0), cA, voffA); PG8_STAGE(PG8_SB(0, 1), cB + hstep, voffB); PG8_STAGE(PG8_SA(0, 1), cA + hstep, voffA);
        if (wr == 1) PG8_BAR;
        PG8_WAIT_V(4); PG8_BAR;
        PG8_STAGE(PG8_SB(1, 0), cB + kstep, voffB); PG8_STAGE(PG8_SA(1, 0), cA + kstep, voffA); PG8_STAGE(PG8_SB(1, 1), cB + hstep + kstep, voffB);
        PG8_WAIT_V(6); PG8_BAR;
    }
    for (;;) {
        const bool has_next = S.next(ui + 1, nxt);
        const char* nA = has_next ? (const char*)g.A + (size_t)nxt.pm * tstep + (size_t)nxt.kb * kstep : cA; const char* nB = has_next ? (const char*)g.Bt + (size_t)nxt.pn * tstep + (size_t)nxt.kb * kstep : cB;
        const int nt = cur.nt;
        for (int t = 0; t < nt; t += 2) {
            const bool last = (t == nt - 2);
            const char* a1 = cA + (size_t)(t + 1) * kstep;
            const char* a2 = last ? nA : cA + (size_t)(t + 2) * kstep; const char* b2 = last ? nB : cB + (size_t)(t + 2) * kstep;
            const char* a3 = a2 + kstep; const char* b3 = b2 + kstep;
            if (last && has_next) S.a_ready(nxt);
            if constexpr (SP2) {
            PG8_LDB(B0, 0, 0); PG8_LDB(B1, 0, 1); PG8_SCHED; PG8_LDA(At, 0, 0); PG8_STAGE(PG8_SA(1, 1), a1 + hstep, voffA);
            PG8_WAIT_V(8); PG8_WAIT_L(0); PG8_BAR; PG8_MMA2(0, 0, At, B0, 0, 1, At, B1); PG8_BAR; PG8_SCHED;
            PG8_LDA(At, 0, 1); PG8_STAGE(PG8_SB(0, 0), b2, voffB); PG8_STAGE(PG8_SB(0, 1), b2 + hstep, voffB); PG8_STAGE(PG8_SA(0, 0), a2, voffA);
            PG8_WAIT_V(8); PG8_WAIT_L(0); PG8_BAR; PG8_MMA2(1, 0, At, B0, 1, 1, At, B1); PG8_BAR; PG8_SCHED;
            PG8_LDB(B0, 1, 0); PG8_LDB(B1, 1, 1); PG8_SCHED; PG8_LDA(At, 1, 0); PG8_STAGE(PG8_SA(0, 1), a2 + hstep, voffA);
            PG8_WAIT_V(8); PG8_WAIT_L(0); PG8_BAR; PG8_MMA2(0, 0, At, B0, 0, 1, At, B1); PG8_BAR; PG8_SCHED;
            PG8_LDA(At, 1, 1); PG8_STAGE(PG8_SB(1, 0), b3, voffB); PG8_STAGE(PG8_SB(1, 1), b3 + hstep, voffB); PG8_STAGE(PG8_SA(1, 0), a3, voffA);
            PG8_WAIT_V(8); PG8_WAIT_L(0); PG8_BAR; PG8_MMA2(1, 0, At, B0, 1, 1, At, B1); PG8_BAR; PG8_SCHED;
            } else {
            PG8_LDB(B0, 0, 0); PG8_SCHED; PG8_LDA(At, 0, 0); PG8_STAGE(PG8_SA(1, 1), a1 + hstep, voffA);
            PG8_WAIT_L(8); PG8_BAR; PG8_WAIT_L(0); PG8_MMA(0, 0, At, B0); PG8_BAR; PG8_SCHED;
            PG8_LDB(B1, 0, 1); PG8_STAGE(PG8_SB(0, 0), b2, voffB);
            PG8_BAR; PG8_WAIT_L(0); PG8_MMA(0, 1, At, B1); PG8_BAR;
            PG8_LDA(At, 0, 1); PG8_STAGE(PG8_SA(0, 0), a2, voffA);
            PG8_BAR; PG8_WAIT_L(0); PG8_MMA(1, 0, At, B0); PG8_BAR; PG8_SCHED;
            PG8_STAGE(PG8_SB(0, 1), b2 + hstep, voffB);
            PG8_WAIT_V(6); PG8_BAR; PG8_MMA(1, 1, At, B1); PG8_BAR;
            PG8_LDB(B0, 1, 0); PG8_SCHED; PG8_LDA(At, 1, 0); PG8_STAGE(PG8_SA(0, 1), a2 + hstep, voffA);
            PG8_WAIT_L(8); PG8_BAR; PG8_WAIT_L(0); PG8_MMA(0, 0, At, B0); PG8_BAR; PG8_SCHED;
            PG8_LDB(B1, 1, 1); PG8_STAGE(PG8_SB(1, 0), b3, voffB);
            PG8_BAR; PG8_WAIT_L(0); PG8_MMA(0, 1, At, B1); PG8_BAR;
            PG8_LDA(At, 1, 1); PG8_STAGE(PG8_SA(1, 0), a3, voffA);
            PG8_BAR; PG8_WAIT_L(0); PG8_MMA(1, 0, At, B0); PG8_BAR; PG8_SCHED;
            PG8_STAGE(PG8_SB(1, 1), b3 + hstep, voffB);
            PG8_WAIT_V(6); PG8_BAR; PG8_MMA(1, 1, At, B1); PG8_BAR;
            }
        }
        if constexpr (ALIGN_EPI) { if (wr == 0) PG8_BAR; }
        if constexpr (!Epi::AFTER_DRAIN) { E(acc, cur, wr, wc, fr, fq); S.done(cur); }
        if (!has_next) break;
#pragma unroll
        for (int a = 0; a < 2; ++a)
#pragma unroll
            for (int b = 0; b < 2; ++b)
#pragma unroll
                for (int m = 0; m < 4; ++m)
#pragma unroll
                    for (int n = 0; n < 2; ++n) acc[a][b][m][n] = (f32x4){0.f, 0.f, 0.f, 0.f};
        cur = nxt; cA = nA; cB = nB; ++ui;
        if constexpr (ALIGN_EPI) { if (wr == 1) PG8_BAR; }
    }
    PG8_WAIT_V(0);
    if constexpr (!ALIGN_EPI) { if (wr == 0) PG8_BAR; }
    PG8_BAR;
    if constexpr (Epi::AFTER_DRAIN) { E.fused(acc, cur, wr, wc, fr, fq, lds, wid, lane); S.done(cur); }
#undef PG8_SA
#undef PG8_SB
#undef PG8_STAGE
#undef PG8_LDA
#undef PG8_LDB
#undef PG8_MMA
#undef PG8_MMA2
#undef PG8_WAIT_V
#undef PG8_WAIT_L
#undef PG8_BAR
#undef PG8_SCHED
}
}
#define GAS __attribute__((address_space(1)))
#define LAS __attribute__((address_space(3)))
typedef unsigned short bf16;
typedef unsigned v4u __attribute__((ext_vector_type(4)));
typedef float f32x4 __attribute__((ext_vector_type(4)));
typedef short bf16x8 __attribute__((ext_vector_type(8)));
typedef GAS unsigned gu32;
typedef GAS unsigned long long gu64;
#define RLX_AGENT __ATOMIC_RELAXED, __HIP_MEMORY_SCOPE_AGENT
#define LDS_WAIT() asm volatile("s_waitcnt lgkmcnt(0)" ::: "memory")
#define VM_WAIT() asm volatile("s_waitcnt vmcnt(0)" ::: "memory")
__device__ __forceinline__ unsigned long long rt() { return __builtin_amdgcn_s_memrealtime(); }
__device__ __forceinline__ unsigned f2bf(float f) { unsigned u = __builtin_bit_cast(unsigned, f); return (u + 0x7fffu + ((u >> 16) & 1u)) >> 16; }
__device__ __forceinline__ unsigned pk2(float lo, float hi) { return f2bf(lo) | (f2bf(hi) << 16); }

#define XB_TMO      128
#define XB_XCNT(j)  (256  + 64 * (j))
#define XB_XSUB(j)  (1280 + 64 * (j))
#define XB_XGEN(j)  (2304 + 64 * (j))
#define XB_TOP      3328
#define XB_TOPGEN   3392
#define XCD_BAR_WORDS 3456
#define XB_SPIN_CAP (1u << 18)

__device__ __forceinline__ unsigned xb_ld(unsigned* p)              { return __hip_atomic_load(p, __ATOMIC_RELAXED, __HIP_MEMORY_SCOPE_AGENT); }
__device__ __forceinline__ unsigned xb_add(unsigned* p, unsigned v) { return __hip_atomic_fetch_add(p, v, __ATOMIC_RELAXED, __HIP_MEMORY_SCOPE_AGENT); }
__device__ __forceinline__ unsigned xb_xcc_id() { return (unsigned)__builtin_amdgcn_s_getreg((3 << 11) | 20) & 0xFu; }
#define XB_SPIN(cond, bar) do { unsigned _sp = 0; while (cond) { __builtin_amdgcn_s_sleep(1); \
    if ((++_sp & 255u) == 0u) { if (xb_ld(&(bar)[XB_TMO])) break; if (_sp > XB_SPIN_CAP) { atomicAdd(&(bar)[XB_TMO], 1u); break; } } } } while (0)

struct XcdBarrier {
    unsigned* bar; unsigned x;
    volatile LAS unsigned* st;
};

__device__ __forceinline__ XcdBarrier xcd_barrier_post(unsigned* bar, volatile LAS unsigned* st) {
    XcdBarrier b; b.bar = bar; b.x = xb_xcc_id(); b.st = st;
    if (threadIdx.x == 0) (void)xb_add(&bar[XB_XCNT(b.x)], 1u);
    return b;
}
__device__ __forceinline__ void xcd_barrier_complete(unsigned* bar, unsigned x, unsigned& nloc, unsigned& nx) {
    const unsigned G = gridDim.x * gridDim.y * gridDim.z;
    unsigned sum, cnt, mine, sp = 0u;
    for (;;) {
        sum = 0u; cnt = 0u; mine = 0u;
#pragma unroll
        for (unsigned j = 0; j < 16; ++j) { const unsigned c = xb_ld(&bar[XB_XCNT(j)]); sum += c; cnt += (c > 0u) ? 1u : 0u; mine = (j == x) ? c : mine; }
        if (sum == G) break;
        __builtin_amdgcn_s_sleep(1);
        if ((++sp & 255u) == 0u) { if (xb_ld(&bar[XB_TMO])) break; if (sp > XB_SPIN_CAP) { atomicAdd(&bar[XB_TMO], 1u); break; } }
    }
    nloc = mine > 0u ? mine : 1u; nx = cnt > 0u ? cnt : 1u;
}

__device__ __forceinline__ void xcd_barrier(const XcdBarrier& b, const bool t0  ) {
    asm volatile("s_waitcnt vmcnt(0)" ::: "memory");
    __syncthreads();
    if (t0) {
        unsigned* bar = b.bar;
        __builtin_amdgcn_s_waitcnt(0);
        unsigned nloc = b.st[0], nx = b.st[1];
        if (nloc == 0u) { xcd_barrier_complete(bar, b.x, nloc, nx); b.st[0] = nloc; b.st[1] = nx; }
        const unsigned old = xb_add(&bar[XB_XSUB(b.x)], 1u);
        const unsigned gen = old / nloc;
        if (old + 1u == (gen + 1u) * nloc) {
            __builtin_amdgcn_fence(__ATOMIC_RELEASE, "agent");
            asm volatile("s_waitcnt vmcnt(0)" ::: "memory");
            const unsigned og = xb_add(&bar[XB_TOP], 1u);
            const unsigned tg = og / nx;
            if (og + 1u == (tg + 1u) * nx) xb_add(&bar[XB_TOPGEN], 1u);
            else XB_SPIN(xb_ld(&bar[XB_TOPGEN]) == tg, bar);
            __builtin_amdgcn_fence(__ATOMIC_ACQUIRE, "agent");
            xb_add(&bar[XB_XGEN(b.x)], 1u);
            asm volatile("s_waitcnt vmcnt(0)" ::: "memory");
        } else {
            XB_SPIN(xb_ld(&bar[XB_XGEN(b.x)]) == gen, bar);
            __builtin_amdgcn_fence(__ATOMIC_ACQUIRE, "agent");
            asm volatile("s_waitcnt vmcnt(0)" ::: "memory");
        }
    }
    __syncthreads();
}

constexpr int DM = 2048, DFF = 5632, INW = 4352, NLAYER = 4;
constexpr int SEQ = 8192, MP = 2 * SEQ, DSEQ = 64, DB = 32, MS = DB * DSEQ, M = MP + MS;
constexpr int C_P = 0, C_H = 512, C_BG = 1280, C_CG = 2048, C_U = 2816, C_V = 3584;
constexpr float EPS = 1e-6f;
constexpr int NWAVES = 8;
constexpr size_t O_YP = 0, O_YS = (size_t)MP * DM, O_PP = (size_t)M * DM, O_CP = O_PP + (size_t)NLAYER * 2 * 15 * 512, O_PS = O_CP + (size_t)NLAYER * 2 * 2 * 768,
                 O_CS = O_PS + (size_t)NLAYER * DB * 15 * 512, O_VS = O_CS + (size_t)NLAYER * DB * 2 * 768, O_END = O_VS + (size_t)NLAYER * DB * DSEQ * 768;
static_assert(O_END == 45293568, "d_out map");
constexpr size_t WS_CTL = 0, CTL_ZERO_BYTES = 64u << 10;
constexpr size_t SZ_WGU = (size_t)2 * DFF * DM * 2, SZ_WD = (size_t)DM * DFF * 2, SZ_WIN = (size_t)INW * DM * 2, SZ_WOUT = (size_t)DM * DM * 2, SZ_POOLW = (size_t)4 * 128 * 128 * 2, SZ_SGUW = (size_t)6 * 128 * 128 * 2;
constexpr size_t WS_WGU = 1u << 20, WS_WD = WS_WGU + 8 * SZ_WGU, WS_WIN = WS_WD + 8 * SZ_WD, WS_WOUT = WS_WIN + 4 * SZ_WIN, WS_POOLW = WS_WOUT + 4 * SZ_WOUT, WS_SGUW = WS_POOLW + 4 * SZ_POOLW;
constexpr size_t WS_XB = WS_SGUW + 4 * SZ_SGUW, WS_H = WS_XB + (size_t)M * DM * 2, WS_D = WS_H + (size_t)M * DFF * 2, WS_DSL = WS_D + (size_t)MP * DM * 2, WS_YU = WS_DSL + (size_t)4 * MS * DM * 4;
constexpr size_t WS_SSX = WS_YU + (size_t)M * DM * 2, WS_GS = WS_SSX + (size_t)M * 4, WS_VT = WS_GS + (size_t)M * 16 * 4, WS_END = WS_VT + (size_t)M * 768 * 2;
static_assert(WS_END <= 1475633152ull, "d_ws map exceeds the guaranteed workspace");
static_assert(WS_XB % 256 == 0 && WS_H % 256 == 0 && WS_D % 256 == 0 && WS_YU % 256 == 0 && WS_SSX % 256 == 0 && WS_DSL % 256 == 0 && WS_GS % 256 == 0, "alignment");
constexpr int CW_BAR = 4096;
constexpr int RING_BYTES = 131072, MISC_OFF = RING_BYTES, LDS_BYTES = RING_BYTES + 1024;

typedef unsigned u32x2 __attribute__((ext_vector_type(2)));
__device__ __forceinline__ float bf2f(unsigned short b) { return __builtin_bit_cast(float, (unsigned)b << 16); }
__device__ __forceinline__ float shx(float v, int o, int lane) { return __builtin_bit_cast(float, __builtin_amdgcn_ds_bpermute((lane ^ o) << 2, __builtin_bit_cast(int, v))); }
__device__ __forceinline__ float wave_sum(float v, int lane) {
#pragma unroll
    for (int o = 1; o < 64; o <<= 1) v += shx(v, o, lane);
    return v;
}
__device__ __forceinline__ void unpack8(bf16x8 v, float (&f)[8]) {
#pragma unroll
    for (int i = 0; i < 8; ++i) f[i] = bf2f((unsigned short)v[i]);
}
__device__ __forceinline__ void unpack4(u32x2 v, float (&f)[4]) {
    f[0] = __builtin_bit_cast(float, v.x << 16); f[1] = __builtin_bit_cast(float, v.x & 0xffff0000u);
    f[2] = __builtin_bit_cast(float, v.y << 16); f[3] = __builtin_bit_cast(float, v.y & 0xffff0000u);
}

struct EpiGateUp {
    static constexpr bool PERM = true, AFTER_DRAIN = false;
    bf16* H; const float* ssx;
    __device__ __forceinline__ void operator()(const pg8::f32x4 (&acc)[2][2][4][2], const pg8::Unit& u, int wr, int wc, int fr, int fq) const {
        const int row0 = u.pm * 256 + wr * 64 + fr, col0 = u.pn * 128 + wc * 32 + 8 * fq;
        float rs[2][4];
#pragma unroll
        for (int ai = 0; ai < 2; ++ai)
#pragma unroll
            for (int m = 0; m < 4; ++m) rs[ai][m] = ssx[row0 + ai * 128 + m * 16];
#pragma unroll
        for (int ai = 0; ai < 2; ++ai)
#pragma unroll
            for (int mp = 0; mp < 2; ++mp) {
                float g[16], uu[16], t[16];
#pragma unroll
                for (int mm = 0; mm < 2; ++mm) { const int m = 2 * mp + mm; const float r = __builtin_amdgcn_rsqf(rs[ai][m] * (1.0f / DM) + EPS);
#pragma unroll
                    for (int n = 0; n < 2; ++n)
#pragma unroll
                        for (int e = 0; e < 4; ++e) { g[8 * mm + 4 * n + e] = acc[ai][0][m][n][e] * r; uu[8 * mm + 4 * n + e] = acc[ai][1][m][n][e] * r; } }
#pragma unroll
                for (int i = 0; i < 16; ++i) t[i] = g[i] * -1.44269504f;
#pragma unroll
                for (int i = 0; i < 16; ++i) t[i] = __builtin_amdgcn_exp2f(t[i]);
#pragma unroll
                for (int i = 0; i < 16; ++i) t[i] = 1.0f + t[i];
#pragma unroll
                for (int i = 0; i < 16; ++i) t[i] = __builtin_amdgcn_rcpf(t[i]);
#pragma unroll
                for (int i = 0; i < 16; ++i) g[i] = g[i] * uu[i];
#pragma unroll
                for (int i = 0; i < 16; ++i) g[i] = g[i] * t[i];
#pragma unroll
                for (int mm = 0; mm < 2; ++mm) { const int row = row0 + ai * 128 + (2 * mp + mm) * 16; const float* hv = g + 8 * mm;
                    v4u w; w.x = pg8::cvt_pk_bf16(hv[0], hv[1]); w.y = pg8::cvt_pk_bf16(hv[2], hv[3]); w.z = pg8::cvt_pk_bf16(hv[4], hv[5]); w.w = pg8::cvt_pk_bf16(hv[6], hv[7]);
                    *(v4u*)(H + (size_t)row * DFF + col0) = w; }
            }
    }
};
struct EpiProj {
    static constexpr bool PERM = true, AFTER_DRAIN = false;
    bf16* P; const float* ssx;
    __device__ __forceinline__ void operator()(const pg8::f32x4 (&acc)[2][2][4][2], const pg8::Unit& u, int wr, int wc, int fr, int fq) const {
        const int row0 = u.pm * 256 + wr * 64 + fr, col0 = u.pn * 256 + wc * 32 + 8 * fq;
        float rs[2][4];
#pragma unroll
        for (int ai = 0; ai < 2; ++ai)
#pragma unroll
            for (int m = 0; m < 4; ++m) rs[ai][m] = ssx[row0 + ai * 128 + m * 16];
#pragma unroll
        for (int ai = 0; ai < 2; ++ai)
#pragma unroll
            for (int m = 0; m < 4; ++m) {
                const int row = row0 + ai * 128 + m * 16;
                const float r = __builtin_amdgcn_rsqf(rs[ai][m] * (1.0f / DM) + EPS);
#pragma unroll
                for (int bj = 0; bj < 2; ++bj) { const pg8::f32x4 v0 = acc[ai][bj][m][0] * r, v1 = acc[ai][bj][m][1] * r;
                    v4u w; w.x = pg8::cvt_pk_bf16(v0[0], v0[1]); w.y = pg8::cvt_pk_bf16(v0[2], v0[3]); w.z = pg8::cvt_pk_bf16(v1[0], v1[1]); w.w = pg8::cvt_pk_bf16(v1[2], v1[3]);
                    *(v4u*)(P + (size_t)row * INW + col0 + bj * 128) = w; }
            }
    }
};
struct EpiVT {
    static constexpr bool PERM = false, AFTER_DRAIN = false;
    bf16* VT; const float* ssx; float* vs;
    __device__ __forceinline__ void operator()(const pg8::f32x4 (&acc)[2][2][4][2], const pg8::Unit& u, int wr, int wc, int fr, int fq) const {
        const int rowb = u.pm * 256 + wr * 64 + 4 * fq, cb = u.pn * 256 - C_V + wc * 32 + fr;
        pg8::f32x4 rs[2][4];
#pragma unroll
        for (int ai = 0; ai < 2; ++ai)
#pragma unroll
            for (int m = 0; m < 4; ++m) rs[ai][m] = *(const pg8::f32x4*)(ssx + rowb + ai * 128 + m * 16);
#pragma unroll
        for (int ai = 0; ai < 2; ++ai)
#pragma unroll
            for (int m = 0; m < 4; ++m) {
                const int row = rowb + ai * 128 + m * 16;
                pg8::f32x4 r;
#pragma unroll
                for (int e = 0; e < 4; ++e) r[e] = __builtin_amdgcn_rsqf(rs[ai][m][e] * (1.0f / DM) + EPS);
#pragma unroll
                for (int bj = 0; bj < 2; ++bj)
#pragma unroll
                    for (int n = 0; n < 2; ++n) { const int c = cb + bj * 128 + n * 16; const pg8::f32x4 v = acc[ai][bj][m][n] * r;
                        u32x2 w; w.x = pg8::cvt_pk_bf16(v[0], v[1]); w.y = pg8::cvt_pk_bf16(v[2], v[3]);
                        *(u32x2*)(VT + ((size_t)(row >> 6) * 768 + c) * 64 + (row & 63)) = w;
                        if (row >= MP) { float* o = vs + (size_t)(row - MP) * 768 + c; o[0] = v[0]; o[768] = v[1]; o[2 * 768] = v[2]; o[3 * 768] = v[3]; } }
            }
    }
};
struct EpiD {
    static constexpr bool PERM = true, AFTER_DRAIN = false;
    bf16* D16; float* DSL;
    __device__ __forceinline__ void operator()(const pg8::f32x4 (&acc)[2][2][4][2], const pg8::Unit& u, int wr, int wc, int fr, int fq) const {
        const int row0 = u.pm * 256 + wr * 64 + fr, col0 = u.pn * 256 + wc * 32 + 8 * fq;
        if (u.slab == 0) {
#pragma unroll
            for (int ai = 0; ai < 2; ++ai)
#pragma unroll
                for (int m = 0; m < 4; ++m) { bf16* rowp = D16 + (size_t)(row0 + ai * 128 + m * 16) * DM + col0;
#pragma unroll
                    for (int bj = 0; bj < 2; ++bj) { const pg8::f32x4 v0 = acc[ai][bj][m][0], v1 = acc[ai][bj][m][1];
                        v4u w; w.x = pg8::cvt_pk_bf16(v0[0], v0[1]); w.y = pg8::cvt_pk_bf16(v0[2], v0[3]); w.z = pg8::cvt_pk_bf16(v1[0], v1[1]); w.w = pg8::cvt_pk_bf16(v1[2], v1[3]);
                        *(v4u*)(rowp + bj * 128) = w; } }
        } else {
            float* base = DSL + (size_t)(u.slab - 1) * MS * DM;
#pragma unroll
            for (int ai = 0; ai < 2; ++ai)
#pragma unroll
                for (int m = 0; m < 4; ++m) { float* rowp = base + (size_t)(row0 + ai * 128 + m * 16 - MP) * DM + col0;
#pragma unroll
                    for (int bj = 0; bj < 2; ++bj) { *(pg8::f32x4*)(rowp + bj * 128) = acc[ai][bj][m][0]; *(pg8::f32x4*)(rowp + bj * 128 + 4) = acc[ai][bj][m][1]; } }
        }
    }
};

__device__ __forceinline__ void cvt_item(const float* W, int K, int N, const float* gain, bf16* WT, int sh, int add, LAS unsigned char* scr, int item, int lane) {
    const int nblk = N >> 7, kb = item / nblk, nb = item - kb * nblk, k0 = kb << 6, n00 = nb << 7;
    const int kq = lane >> 4, nq = lane & 15;
    const float* src = W + (size_t)(k0 + 16 * kq) * N + n00 + 4 * nq;
    f32x4 v[2][16];
#pragma unroll
    for (int i = 0; i < 16; ++i) { v[0][i] = __builtin_nontemporal_load((const f32x4*)(src + (size_t)i * N)); v[1][i] = __builtin_nontemporal_load((const f32x4*)(src + (size_t)i * N + 64)); }
    f32x4 g4[4];
    if (gain) { const f32x4* gp = (const f32x4*)(gain + k0 + 16 * kq);
#pragma unroll
        for (int i4 = 0; i4 < 4; ++i4) g4[i4] = gp[i4]; }
    else {
#pragma unroll
        for (int i4 = 0; i4 < 4; ++i4) g4[i4] = (f32x4){1.f, 1.f, 1.f, 1.f}; }
    const int r = lane >> 3, c8 = lane & 7;
#pragma unroll
    for (int hf = 0; hf < 2; ++hf) {
        const int n0 = n00 + 64 * hf;
#pragma unroll
        for (int c = 0; c < 4; ++c) {
            float t[16];
#pragma unroll
            for (int i = 0; i < 16; ++i) t[i] = v[hf][i][c] * g4[i >> 2][i & 3];
            v4u lo, hi;
            lo.x = pg8::cvt_pk_bf16(t[0], t[1]); lo.y = pg8::cvt_pk_bf16(t[2], t[3]); lo.z = pg8::cvt_pk_bf16(t[4], t[5]); lo.w = pg8::cvt_pk_bf16(t[6], t[7]);
            hi.x = pg8::cvt_pk_bf16(t[8], t[9]); hi.y = pg8::cvt_pk_bf16(t[10], t[11]); hi.z = pg8::cvt_pk_bf16(t[12], t[13]); hi.w = pg8::cvt_pk_bf16(t[14], t[15]);
            LAS unsigned char* p = scr + (4 * nq + c) * 144 + 32 * kq;
            *(LAS v4u*)p = lo; *(LAS v4u*)(p + 16) = hi;
        }
        LDS_WAIT(); asm volatile("" ::: "memory");
#pragma unroll
        for (int j = 0; j < 8; ++j) { const int n = 8 * j + r; const v4u o = *(const LAS v4u*)(scr + n * 144 + 16 * c8);
            const int nn = n0 + n, orow = ((nn >> 7) << sh) + add + (nn & 127);
            *(v4u*)(WT + (size_t)orow * K + k0 + 8 * c8) = o; }
        LDS_WAIT(); asm volatile("" ::: "memory");
    }
}

__device__ __forceinline__ void ew_phase(float* Y, bf16* XB, float* SSX, const bf16* D16, const float* DSL, const float* gain, float alpha, bool last, int gw, int ngw, int lane) {
    for (int row = gw; row < M; row += ngw) {
        f32x4 dv[8];
        if (row < MP) { const u32x2* dr = (const u32x2*)(D16 + (size_t)row * DM) + lane;
#pragma unroll
            for (int j = 0; j < 8; ++j) { float t[4]; unpack4(dr[64 * j], t); dv[j] = (f32x4){t[0], t[1], t[2], t[3]}; } }
        else { const f32x4* dr = (const f32x4*)(DSL + (size_t)(row - MP) * DM) + lane;
#pragma unroll
            for (int j = 0; j < 8; ++j) dv[j] = (dr[64 * j] + dr[64 * j + (size_t)MS * DM / 4]) + (dr[64 * j + (size_t)2 * MS * DM / 4] + dr[64 * j + (size_t)3 * MS * DM / 4]); }
        const f32x4* gr = (const f32x4*)gain + lane; u32x2* xb = (u32x2*)(XB + (size_t)row * DM) + lane;
        f32x4 xv[8]; float sd = 0.f;
#pragma unroll
        for (int j = 0; j < 8; ++j) { float t[4]; unpack4(xb[64 * j], t); xv[j] = (f32x4){t[0], t[1], t[2], t[3]}; const f32x4 d = dv[j]; sd += (d[0] * d[0] + d[1] * d[1]) + (d[2] * d[2] + d[3] * d[3]); }
        sd = wave_sum(sd, lane);
        const float sc = __builtin_amdgcn_rsqf(sd * (1.0f / DM) + EPS) * alpha;
        float ss = 0.f;
        if (!last) {
#pragma unroll
            for (int j = 0; j < 8; ++j) { const f32x4 g = gr[64 * j]; const f32x4 x = xv[j] + dv[j] * g * sc;
                u32x2 w; w.x = pg8::cvt_pk_bf16(x[0], x[1]); w.y = pg8::cvt_pk_bf16(x[2], x[3]); xb[64 * j] = w; ss += (x[0] * x[0] + x[1] * x[1]) + (x[2] * x[2] + x[3] * x[3]); }
            ss = wave_sum(ss, lane); if (lane == 0) SSX[row] = ss;
        } else { f32x4* yr = (f32x4*)(Y + (size_t)row * DM) + lane;
#pragma unroll
            for (int j = 0; j < 8; ++j) { const f32x4 g = gr[64 * j]; yr[64 * j] = xv[j] + dv[j] * g * sc; } }
    }
}

template <int W>
__device__ __forceinline__ bf16x8 pool_frag_fast(const bf16* ub  , int loff  ) {
    bf16x8 q[W];
#pragma unroll
    for (int jj = 0; jj < W; ++jj) q[jj] = *(const bf16x8*)(ub - (size_t)jj * INW + loff);
    float s[8], p0[8]; unpack8(q[0], p0);
#pragma unroll
    for (int i = 0; i < 8; ++i) s[i] = p0[i];
#pragma unroll
    for (int jj = 1; jj < W; ++jj) { float v[8]; unpack8(q[jj], v);
#pragma unroll
        for (int i = 0; i < 8; ++i) s[i] += v[i]; }
    bf16x8 d;
#pragma unroll
    for (int i = 0; i < 8; ++i) d[i] = (short)f2bf(s[i] * (1.0f / W) - p0[i]);
    return d;
}
template <int W>
__device__ __forceinline__ bf16x8 pool_frag_first(const bf16* ub  , const float* hb  , bool samp, int tr, int kq) {
    bf16x8 q[W];
#pragma unroll
    for (int jj = 0; jj < W; ++jj) { const int tt = tr - jj; q[jj] = *(const bf16x8*)(ub + (tt < 0 ? 0 : tt) * INW + 8 * kq); }
    float s[8], p0[8]; unpack8(q[0], p0);
#pragma unroll
    for (int i = 0; i < 8; ++i) s[i] = p0[i];
#pragma unroll
    for (int jj = 1; jj < W; ++jj) { float v[8]; unpack8(q[jj], v); const bool ok = tr >= jj;
#pragma unroll
        for (int i = 0; i < 8; ++i) s[i] += ok ? v[i] : 0.f; }
    float invc = 1.0f / (float)((tr + 1) < W ? (tr + 1) : W);
    if (samp) {
        constexpr int GRP = 5;
#pragma unroll
        for (int j0 = 1; j0 < W; j0 += GRP) {
            __builtin_amdgcn_sched_barrier(0);
            f32x4 ha[GRP], hc[GRP];
#pragma unroll
            for (int k = 0; k < GRP; ++k) if (j0 + k < W) { const int hr = 15 + tr - (j0 + k); const float* hp = hb + (hr > 14 ? 14 : hr) * 512 + 8 * kq; ha[k] = *(const f32x4*)hp; hc[k] = *(const f32x4*)(hp + 4); }
#pragma unroll
            for (int k = 0; k < GRP; ++k) if (j0 + k < W) { const bool use = tr < j0 + k;
#pragma unroll
                for (int i = 0; i < 4; ++i) { s[i] += use ? ha[k][i] : 0.f; s[4 + i] += use ? hc[k][i] : 0.f; } }
        }
        invc = 1.0f / (float)W;
    }
    bf16x8 d;
#pragma unroll
    for (int i = 0; i < 8; ++i) d[i] = (short)f2bf(s[i] * invc - p0[i]);
    return d;
}
__device__ __forceinline__ float pool_compute(int l, int tb, int g, const bf16* PROJ, const float* state_pool, const bf16* POOLW, f32x4 (&acc)[8], int lane) {
    asm volatile("" : "+v"(lane));
    const int r0 = tb * 16, tr = lane & 15, kq = lane >> 4;
    const bool samp = r0 >= MP;
    int seq0, tloc0, sb = 0;
    if (!samp) { seq0 = r0 & ~(SEQ - 1); tloc0 = r0 & (SEQ - 1); } else { sb = (r0 - MP) >> 6; seq0 = MP + (sb << 6); tloc0 = (r0 - MP) & 63; }
    bf16x8 dfr[4];
    const bf16* pb = PROJ + (size_t)(seq0 + tloc0) * INW + C_P + g * 128;
    const int loff = tr * INW + 8 * kq;
    if (tloc0 == 0) {
        const float* hb = state_pool + (size_t)(l * DB + sb) * 15 * 512 + g * 128;
#pragma unroll
        for (int kt = 0; kt < 4; ++kt) {
            if (g == 0) dfr[kt] = pool_frag_first<2>(pb + 32 * kt, hb + 32 * kt, samp, tr, kq);
            else if (g == 1) dfr[kt] = pool_frag_first<4>(pb + 32 * kt, hb + 32 * kt, samp, tr, kq);
            else if (g == 2) dfr[kt] = pool_frag_first<8>(pb + 32 * kt, hb + 32 * kt, samp, tr, kq);
            else dfr[kt] = pool_frag_first<16>(pb + 32 * kt, hb + 32 * kt, samp, tr, kq);
            __builtin_amdgcn_sched_barrier(0);
        }
    } else if (g == 0) {
#pragma unroll
        for (int kt = 0; kt < 4; ++kt) dfr[kt] = pool_frag_fast<2>(pb + 32 * kt, loff);
    } else if (g == 1) {
#pragma unroll
        for (int kt = 0; kt < 4; ++kt) dfr[kt] = pool_frag_fast<4>(pb + 32 * kt, loff);
    } else if (g == 2) {
#pragma unroll
        for (int kt = 0; kt < 4; ++kt) dfr[kt] = pool_frag_fast<8>(pb + 32 * kt, loff);
    } else {
#pragma unroll
        for (int kt = 0; kt < 4; ++kt) { dfr[kt] = pool_frag_fast<16>(pb + 32 * kt, loff); if (kt == 1) __builtin_amdgcn_sched_barrier(0); }
    }
#pragma unroll
    for (int dt = 0; dt < 8; ++dt) acc[dt] = (f32x4){0.f, 0.f, 0.f, 0.f};
    const bf16* Wg = POOLW + (size_t)(l * 4 + g) * 128 * 128; const int woff = tr * 128 + 8 * kq;
    bf16x8 wf[4][8];
#pragma unroll
    for (int kt = 0; kt < 4; ++kt)
#pragma unroll
        for (int dt = 0; dt < 8; ++dt) wf[kt][dt] = *(const bf16x8*)(Wg + (16 * dt) * 128 + 32 * kt + woff);
    __builtin_amdgcn_sched_barrier(0);
#pragma unroll
    for (int kt = 0; kt < 4; ++kt)
#pragma unroll
        for (int dt = 0; dt < 8; ++dt) acc[dt] = __builtin_amdgcn_mfma_f32_16x16x32_bf16(wf[kt][dt], dfr[kt], acc[dt], 0, 0, 0);
    __builtin_amdgcn_sched_barrier(0);
    float ss = 0.f;
#pragma unroll
    for (int dt = 0; dt < 8; ++dt) { const f32x4 a = acc[dt]; ss += (a[0] * a[0] + a[1] * a[1]) + (a[2] * a[2] + a[3] * a[3]); }
    ss += shx(ss, 16, lane); ss += shx(ss, 32, lane);
    return ss;
}
__device__ __forceinline__ void tile_store(const f32x4 (&v)[8], float r, bf16* dst  ) {
#pragma unroll
    for (int dt = 0; dt < 8; ++dt) { const f32x4 a = v[dt] * r; u32x2 o; o.x = pg8::cvt_pk_bf16(a[0], a[1]); o.y = pg8::cvt_pk_bf16(a[2], a[3]); *(u32x2*)(dst + 16 * dt) = o; }
}
__device__ __forceinline__ void conv_z(int l, int seq0, int tt, bool samp, int sb, int c, const bf16* PROJ, const float* state_conv, float (&z)[4]) {
    if (tt >= 0) { float h[4], cg[4]; unpack4(*(const u32x2*)(PROJ + (size_t)(seq0 + tt) * INW + C_H + c), h); unpack4(*(const u32x2*)(PROJ + (size_t)(seq0 + tt) * INW + C_CG + c), cg);
#pragma unroll
        for (int i = 0; i < 4; ++i) z[i] = cg[i] * h[i]; }
    else if (samp) { const f32x4 a = *(const f32x4*)(state_conv + ((size_t)(l * DB + sb) * 2 + 2 + tt) * 768 + c); z[0] = a[0]; z[1] = a[1]; z[2] = a[2]; z[3] = a[3]; }
    else { z[0] = 0.f; z[1] = 0.f; z[2] = 0.f; z[3] = 0.f; }
}
__device__ __forceinline__ void conv_quad(int l, int q, const bf16* PROJ, const float* state_conv, const float* conv_w, bf16* YU, int lane) {
    asm volatile("" : "+v"(lane));
    const int row0 = 4 * q; const bool samp = row0 >= MP; int seq0, tloc0, sb = 0;
    if (!samp) { seq0 = row0 & ~(SEQ - 1); tloc0 = row0 & (SEQ - 1); } else { sb = (row0 - MP) >> 6; seq0 = MP + (sb << 6); tloc0 = (row0 - MP) & 63; }
    float ss[4] = {0.f, 0.f, 0.f, 0.f}; float y[3][4][4];
#pragma unroll
    for (int j = 0; j < 3; ++j) {
        const int c = 256 * j + 4 * lane;
        float zz[6][4];
#pragma unroll
        for (int k = 0; k < 6; ++k) conv_z(l, seq0, tloc0 - 2 + k, samp, sb, c, PROJ, state_conv, zz[k]);
        u32x2 bgr[4];
#pragma unroll
        for (int i = 0; i < 4; ++i) bgr[i] = *(const u32x2*)(PROJ + (size_t)(row0 + i) * INW + C_BG + c);
        const f32x4 w0 = *(const f32x4*)(conv_w + (size_t)(l * 3 + 0) * 768 + c), w1 = *(const f32x4*)(conv_w + (size_t)(l * 3 + 1) * 768 + c), w2 = *(const f32x4*)(conv_w + (size_t)(l * 3 + 2) * 768 + c);
#pragma unroll
        for (int i = 0; i < 4; ++i) { float bg[4]; unpack4(bgr[i], bg);
#pragma unroll
            for (int e = 0; e < 4; ++e) { const float v = bg[e] * (zz[i][e] * w0[e] + zz[i + 1][e] * w1[e] + zz[i + 2][e] * w2[e]); y[j][i][e] = v; ss[i] += v * v; } }
    }
#pragma unroll
    for (int i = 0; i < 4; ++i) { const float r = __builtin_amdgcn_rsqf(wave_sum(ss[i], lane) * (1.0f / 768.0f) + EPS);
#pragma unroll
        for (int j = 0; j < 3; ++j) { u32x2 o; o.x = pg8::cvt_pk_bf16(y[j][i][0] * r, y[j][i][1] * r); o.y = pg8::cvt_pk_bf16(y[j][i][2] * r, y[j][i][3] * r);
            *(u32x2*)(YU + (size_t)(row0 + i) * DM + 512 + 256 * j + 4 * lane) = o; } }
}
__device__ __forceinline__ float sgu_compute(int l, int tb, int h, const bf16* PROJ, const bf16* VT, const bf16* SGUW, const float* sgu_b, f32x4 (&acc)[8], int lane) {
    asm volatile("" : "+v"(lane));
    const int r0 = tb * 16, tr = lane & 15, kq = lane >> 4;
    const bool samp = r0 >= MP;
    const int chunk0 = samp ? (MP + ((r0 - MP) & ~63)) : (r0 & ~127), s0 = r0 - chunk0;
    const int nkk = samp ? 2 : 4;
    const int row = r0 + tr;
    u32x2 uraw[8];
#pragma unroll
    for (int ct = 0; ct < 8; ++ct) uraw[ct] = *(const u32x2*)(PROJ + (size_t)row * INW + C_U + h * 128 + 16 * ct + 4 * kq);
    const float bias = sgu_b[(size_t)(l * 6 + h) * 128 + s0 + tr];
#pragma unroll
    for (int ct = 0; ct < 8; ++ct) acc[ct] = (f32x4){0.f, 0.f, 0.f, 0.f};
    const bf16* Wrow = SGUW + ((size_t)(l * 6 + h) * 128 + s0) * 128; const int woff = tr * 128 + 8 * kq;
    const bf16* Vb = VT + ((size_t)(chunk0 >> 6) * 768 + h * 128) * 64; const int voff = tr * 64 + 8 * kq;
    bf16x8 wf[4], vf[4][8];
#pragma unroll
    for (int kt = 0; kt < 4; ++kt) if (kt < nkk) {
        wf[kt] = *(const bf16x8*)(Wrow + 32 * kt + woff);
        const bf16* vp = Vb + (size_t)(kt >> 1) * 768 * 64 + 32 * (kt & 1);
#pragma unroll
        for (int ct = 0; ct < 8; ++ct) vf[kt][ct] = *(const bf16x8*)(vp + (16 * ct) * 64 + voff);
    }
    __builtin_amdgcn_sched_barrier(0);
#pragma unroll
    for (int kt = 0; kt < 4; ++kt) if (kt < nkk) {
#pragma unroll
        for (int ct = 0; ct < 8; ++ct) acc[ct] = __builtin_amdgcn_mfma_f32_16x16x32_bf16(vf[kt][ct], wf[kt], acc[ct], 0, 0, 0);
    }
    __builtin_amdgcn_sched_barrier(0);
    float ss = 0.f;
#pragma unroll
    for (int ct = 0; ct < 8; ++ct) { float uu[4]; unpack4(uraw[ct], uu); f32x4 a = acc[ct];
#pragma unroll
        for (int i = 0; i < 4; ++i) { a[i] = uu[i] * (a[i] + bias); ss += a[i] * a[i]; }
        acc[ct] = a; }
    ss += shx(ss, 16, lane); ss += shx(ss, 32, lane);
    return ss;
}
__device__ __forceinline__ void sgu_chunk(int l, int cu, const bf16* PROJ, const bf16* VT, const bf16* SGUW, const float* sgu_b, bf16* YU, LAS unsigned char* vbuf, int wave, int lane) {
    const bool samp = cu >= 128;
    const int chunk0 = samp ? (MP + (cu - 128) * DSEQ) : cu * 128, nst = samp ? 4 : 8, npc = samp ? 2 : 4;
    const int tid = wave * 64 + lane, tr = lane & 15, kq = lane >> 4;
    const int s0 = 16 * wave; const bool active = wave < nst; const int row = chunk0 + s0 + tr;
    const int nk = (s0 + 47) >> 5;
    const bf16* vsrc = VT + (size_t)(chunk0 >> 6) * 768 * 64;
    v4u st[4];
#pragma unroll
    for (int i = 0; i < 4; ++i) if (i < npc) { const int q = tid + 512 * i; st[i] = *(const v4u*)(vsrc + (size_t)(q >> 10) * 768 * 64 + (q & 1023) * 8); } else st[i] = (v4u){0u, 0u, 0u, 0u};
#pragma unroll
    for (int i = 0; i < 4; ++i) if (i < npc) *(LAS v4u*)(vbuf + (tid + 512 * i) * 16) = st[i];
    LDS_WAIT(); __builtin_amdgcn_s_barrier(); asm volatile("" ::: "memory");
    u32x2 ypk[6][8]; float ss = 0.f;
#pragma unroll
    for (int h = 0; h < 6; ++h) {
        if (h + 1 < 6) {
#pragma unroll
            for (int i = 0; i < 4; ++i) if (i < npc) { const int q = tid + 512 * i; st[i] = *(const v4u*)(vsrc + (size_t)(h + 1) * 128 * 64 + (size_t)(q >> 10) * 768 * 64 + (q & 1023) * 8); }
        }
        const LAS unsigned char* vb = vbuf + (h & 1) * 32768 + tr * 128 + kq * 16;
        if (active) {
            u32x2 uraw[8];
#pragma unroll
            for (int ct = 0; ct < 8; ++ct) uraw[ct] = *(const u32x2*)(PROJ + (size_t)row * INW + C_U + h * 128 + 16 * ct + 4 * kq);
            const float bias = sgu_b[(size_t)(l * 6 + h) * 128 + s0 + tr];
            const bf16* Wrow = SGUW + ((size_t)(l * 6 + h) * 128 + s0) * 128 + tr * 128 + 8 * kq;
            bf16x8 wf[4];
#pragma unroll
            for (int kt = 0; kt < 4; ++kt) wf[kt] = (kt < nk) ? *(const bf16x8*)(Wrow + 32 * kt) : (bf16x8){0, 0, 0, 0, 0, 0, 0, 0};
            f32x4 acc[8];
#pragma unroll
            for (int ct = 0; ct < 8; ++ct) acc[ct] = (f32x4){0.f, 0.f, 0.f, 0.f};
#pragma unroll
            for (int kt = 0; kt < 4; ++kt) if (kt < nk) {
#pragma unroll
                for (int ct = 0; ct < 8; ++ct) { const bf16x8 vf = *(const LAS bf16x8*)(vb + (kt >> 1) * 16384 + (kt & 1) * 64 + ct * 2048);
                    acc[ct] = __builtin_amdgcn_mfma_f32_16x16x32_bf16(vf, wf[kt], acc[ct], 0, 0, 0); }
            }
#pragma unroll
            for (int ct = 0; ct < 8; ++ct) { float uu[4], y[4]; unpack4(uraw[ct], uu);
#pragma unroll
                for (int i = 0; i < 4; ++i) { y[i] = uu[i] * (acc[ct][i] + bias); ss += y[i] * y[i]; }
                ypk[h][ct].x = pg8::cvt_pk_bf16(y[0], y[1]); ypk[h][ct].y = pg8::cvt_pk_bf16(y[2], y[3]); }
        } else {
#pragma unroll
            for (int ct = 0; ct < 8; ++ct) ypk[h][ct] = (u32x2){0u, 0u};
        }
        if (h + 1 < 6) {
#pragma unroll
            for (int i = 0; i < 4; ++i) if (i < npc) *(LAS v4u*)(vbuf + ((h + 1) & 1) * 32768 + (tid + 512 * i) * 16) = st[i];
        }
        LDS_WAIT(); __builtin_amdgcn_s_barrier(); asm volatile("" ::: "memory");
    }
    if (active) {
        ss += shx(ss, 16, lane); ss += shx(ss, 32, lane);
        const float r = __builtin_amdgcn_rsqf(ss * (1.0f / 768.0f) + EPS);
#pragma unroll
        for (int h = 0; h < 6; ++h)
#pragma unroll
            for (int ct = 0; ct < 8; ++ct) { float y[4]; unpack4(ypk[h][ct], y); u32x2 o; o.x = pg8::cvt_pk_bf16(y[0] * r, y[1] * r); o.y = pg8::cvt_pk_bf16(y[2] * r, y[3] * r);
                *(u32x2*)(YU + (size_t)row * DM + 1280 + h * 128 + 16 * ct + 4 * kq) = o; }
    }
}

constexpr int I_BIG = (DM / 64) * (DFF / 128), I_IN = (DM / 64) * (INW / 128), I_OUT = (DM / 64) * (DM / 128), I_LAYER = 6 * I_BIG + I_IN + I_OUT;
static_assert(I_BIG == (DFF / 64) * (DM / 128) && DFF % 128 == 0 && INW % 128 == 0, "gate/up and down item counts match");
constexpr int GU_UNITS = (M / 256) * (2 * DFF / 256), TAIL_WG0 = GU_UNITS - (GU_UNITS / 256) * 256, TAIL_WAVES = (256 - TAIL_WG0) * NWAVES, TAIL_N = 2, TAIL_ITEMS = TAIL_WAVES * TAIL_N;
static_assert(TAIL_WG0 == 96 && 2 * TAIL_ITEMS <= I_LAYER, "tail conversion split");
__device__ __forceinline__ void cvt_layer_item(const float* const* in, unsigned char* ws, int l, int r, LAS unsigned char* scr, int lane) {
    const float* norm_gains = in[17];
    const float* W; const float* gain; bf16* WT; int K, N, sh = 7, add = 0;
    if (r < 4 * I_BIG) { const int j = r / I_BIG; r -= j * I_BIG; const int f = j >> 1, up = j & 1;
        W = in[11 + 3 * f + up] + (size_t)l * DM * DFF; gain = norm_gains + (size_t)(l * 6 + 4 * f) * DM; WT = (bf16*)(ws + WS_WGU) + (size_t)(2 * l + f) * (2 * DFF * DM); K = DM; N = DFF; sh = 8; add = 128 * up; }
    else if (r < 6 * I_BIG) { r -= 4 * I_BIG; const int f = r / I_BIG; r -= f * I_BIG;
        W = in[13 + 3 * f] + (size_t)l * DFF * DM; gain = nullptr; WT = (bf16*)(ws + WS_WD) + (size_t)(2 * l + f) * (DM * DFF); K = DFF; N = DM; }
    else if (r < 6 * I_BIG + I_IN) { r -= 6 * I_BIG; W = in[4] + (size_t)l * DM * INW; gain = norm_gains + (size_t)(l * 6 + 2) * DM; WT = (bf16*)(ws + WS_WIN) + (size_t)l * (INW * DM); K = DM; N = INW; }
    else { r -= 6 * I_BIG + I_IN; W = in[5] + (size_t)l * DM * DM; gain = in[18] + (size_t)l * DM; WT = (bf16*)(ws + WS_WOUT) + (size_t)l * (DM * DM); K = DM; N = DM; }
    cvt_item(W, K, N, gain, WT, sh, add, scr, r, lane);
}

struct Args { const float* in[19]; float* out; unsigned char* ws; int step_lo, step_hi, use_bar, pad; };
constexpr int N_STEPS = 1 + 8 * 8;
#ifndef GP_ALIGN
#define GP_ALIGN true
#endif
#ifndef GP_SP2
#define GP_SP2 true
#endif
#ifndef MIXP
#define MIXP 0
#endif
#ifndef PROBE_DUP
#define PROBE_DUP 0
#endif
#define REPS(bit) (((PROBE_DUP >> (bit)) & 1) ? 2 : 1)
#define PHASE_ENV \
    int z_ = 0; asm volatile("" : "+s"(z_)); \
    const int lane = (int)__builtin_amdgcn_mbcnt_hi(~0u, __builtin_amdgcn_mbcnt_lo(~0u, (unsigned)z_)); \
    const int wave = __builtin_amdgcn_readfirstlane(wave0 + z_); const int tid = wave * 64 + lane; \
    const int G = (int)gridDim.x, bx = (int)blockIdx.x + z_; \
    const int vcu = (G % 8 == 0) ? (bx % 8) * (G / 8) + bx / 8 : bx; \
    const int gw = vcu * NWAVES + wave, ngw = G * NWAVES; \
    unsigned char* ws = args.ws + z_; float* out = args.out + z_; float* X = out; \
    bf16* XB = (bf16*)(ws + WS_XB); bf16* HB = (bf16*)(ws + WS_H); bf16* PROJ = HB; bf16* D16 = (bf16*)(ws + WS_D); float* DSL = (float*)(ws + WS_DSL); bf16* YU = (bf16*)(ws + WS_YU); \
    float* SSX = (float*)(ws + WS_SSX); \
    (void)lane; (void)tid; (void)gw; (void)ngw; (void)X; (void)XB; (void)HB; (void)PROJ; (void)D16; (void)DSL; (void)YU; (void)SSX; (void)bx;

__global__ void __launch_bounds__(NWAVES * 64, 2) fwd(Args args) {
    extern __shared__ __attribute__((aligned(16))) unsigned char lds_raw[];
    LAS unsigned char* lds = (LAS unsigned char*)lds_raw;
    volatile LAS unsigned* MISC = (volatile LAS unsigned*)(lds + MISC_OFF);
    const int wave0 = __builtin_amdgcn_readfirstlane((int)threadIdx.x >> 6);
    for (int u = threadIdx.x; u < (LDS_BYTES - MISC_OFF) / 4; u += NWAVES * 64) MISC[u] = 0u;
    __syncthreads();
    XcdBarrier bar; bar.bar = (unsigned*)(args.ws + WS_CTL) + CW_BAR; bar.x = 0; bar.st = nullptr;
    if (args.use_bar) bar = xcd_barrier_post((unsigned*)(args.ws + WS_CTL) + CW_BAR, MISC + 8);
#define GRID_BAR() do { if (args.use_bar) xcd_barrier(bar, tid == 0); } while (0)
    const int lo = args.step_lo, hi = args.step_hi;
#define IN(k) (lo <= (k) && (k) < hi)

    if (IN(0)) for (int rep = 0; rep < REPS(0); ++rep) {
        PHASE_ENV
        bf16* POOLW = (bf16*)(ws + WS_POOLW); bf16* SGUW = (bf16*)(ws + WS_SGUW);
        LAS unsigned char* scr = lds + wave * 16384;
        constexpr int I_REST = I_LAYER - 2 * TAIL_ITEMS;
        for (int it = gw; it < I_LAYER + (NLAYER - 1) * I_REST; it += ngw) {
            int l = 0, r = it;
            if (it >= I_LAYER) { l = 1 + (it - I_LAYER) / I_REST; r = 2 * TAIL_ITEMS + (it - I_LAYER) % I_REST; }
            cvt_layer_item(args.in, ws, l, r, scr, lane);
        }
        const int gt = vcu * (NWAVES * 64) + tid, ngt = G * NWAVES * 64;
        const float* pool_w = args.in[6]; const float* pool_scale = args.in[7]; const float* sgu_w = args.in[9];
        for (int o = gt; o < NLAYER * 4 * 128 * 128; o += ngt) {
            const int c = o & 127, d = (o >> 7) & 127, lg = o >> 14; POOLW[o] = (bf16)f2bf(pool_w[((size_t)lg * 128 + c) * 128 + d] * pool_scale[(size_t)lg * 128 + d]); }
        for (int o = gt; o < NLAYER * 6 * 128 * 128; o += ngt) {
            const int t = o & 127, sr = (o >> 7) & 127; SGUW[o] = (t <= sr) ? (bf16)f2bf(sgu_w[o]) : (bf16)0; }
        const float* x_prompt = args.in[0]; const float* x_sample = args.in[1];
        for (int row = gw; row < M; row += ngw) {
            const f32x4* src = (const f32x4*)(row < MP ? x_prompt + (size_t)row * DM : x_sample + (size_t)(row - MP) * DM) + lane;
            u32x2* xb = (u32x2*)(XB + (size_t)row * DM) + lane; float ss = 0.f;
#pragma unroll
            for (int j = 0; j < 8; ++j) { const f32x4 x = src[64 * j]; u32x2 w; w.x = pg8::cvt_pk_bf16(x[0], x[1]); w.y = pg8::cvt_pk_bf16(x[2], x[3]); xb[64 * j] = w;
                ss += (x[0] * x[0] + x[1] * x[1]) + (x[2] * x[2] + x[3] * x[3]); }
            ss = wave_sum(ss, lane); if (lane == 0) SSX[row] = ss;
        }
        GRID_BAR();
    }

    for (int s = 0; s < 8; ++s) {
        const int l = s >> 1, f = s & 1, base = 1 + s * 8;
        if (IN(base + 0)) for (int rep = 0; rep < REPS(1); ++rep) {
            PHASE_ENV
            pg8::Gemm g{XB, (bf16*)(ws + WS_WGU) + (size_t)s * (2 * DFF * DM), M, 2 * DFF, DM}; pg8::StaticOrder S; S.init(M, 2 * DFF, DM, G, bx);
            EpiGateUp E{HB, SSX};
            pg8::gemm_phase<EpiGateUp, pg8::StaticOrder, GP_ALIGN, GP_SP2>(lds, g, S, E, tid);
            if (l + 1 < NLAYER && bx >= TAIL_WG0 && rep == 0) {
                const int widx = (bx - TAIL_WG0) * NWAVES + wave;
                for (int k = 0; k < TAIL_N; ++k) cvt_layer_item(args.in, ws, l + 1, f * TAIL_ITEMS + k * TAIL_WAVES + widx, lds + wave * 16384, lane);
            }
            GRID_BAR();
        }
        if (IN(base + 1)) for (int rep = 0; rep < REPS(2); ++rep) {
            PHASE_ENV
            pg8::Gemm g{HB, (bf16*)(ws + WS_WD) + (size_t)s * (DM * DFF), M, DM, DFF}; pg8::SplitOrder S; S.init(DFF, bx);
            EpiD E{D16, DSL};
            pg8::gemm_phase<EpiD, pg8::SplitOrder, GP_ALIGN, GP_SP2>(lds, g, S, E, tid);
            GRID_BAR();
        }
        if (IN(base + 2)) for (int rep = 0; rep < REPS(3); ++rep) { PHASE_ENV ew_phase(X, XB, SSX, D16, DSL, args.in[17] + (size_t)(l * 6 + (f ? 5 : 1)) * DM, (rep + 1 == REPS(3)) ? 0.5f : 0.0f, s == 7 && rep + 1 == REPS(3), gw, ngw, lane); GRID_BAR(); }
        if (f == 0) {
            if (IN(base + 3)) for (int rep = 0; rep < REPS(4); ++rep) {
                PHASE_ENV
                pg8::Gemm g{XB, (bf16*)(ws + WS_WIN) + (size_t)l * (INW * DM), M, INW, DM};
                { pg8::StaticOrder S; S.init(M, C_V, DM, G, bx, 0); EpiProj E{PROJ, SSX};
                  pg8::gemm_phase<EpiProj, pg8::StaticOrder, GP_ALIGN, GP_SP2>(lds, g, S, E, tid); }
                { pg8::StaticOrder S; S.init(M, INW - C_V, DM, G, bx, C_V / 256); EpiVT E{(bf16*)(ws + WS_VT), SSX, out + O_VS + (size_t)l * MS * 768};
                  pg8::gemm_phase<EpiVT, pg8::StaticOrder, GP_ALIGN, GP_SP2, true>(lds, g, S, E, tid); }
                GRID_BAR();
            }
            if (IN(base + 4)) for (int rep = 0; rep < REPS(5); ++rep) {
                {
                PHASE_ENV
                const float* state_pool = args.in[2]; const float* state_conv = args.in[3]; const float* conv_w = args.in[8]; const float* sgu_b = args.in[10];
                const bf16* POOLW = (const bf16*)(ws + WS_POOLW); const bf16* SGUW = (const bf16*)(ws + WS_SGUW);
                const bf16* VT = (const bf16*)(ws + WS_VT);
                if (vcu < 160) sgu_chunk(l, vcu, PROJ, VT, SGUW, sgu_b, YU, lds, wave, lane);
                LAS float* tab = (LAS float*)(lds + 65536); int par = 0;
                const int npass = (vcu >= 192) ? 3 : 2;
                for (int k = 0; k < npass; ++k, par ^= 1) {
                    int zp = 0; asm volatile("" : "+s"(zp));
                    const int ln = (int)__builtin_amdgcn_mbcnt_hi(~0u, __builtin_amdgcn_mbcnt_lo(~0u, (unsigned)zp));
                    const int tr = ln & 15, kq = ln >> 4, g = wave & 3;
                    int pass;
                    if (vcu < 160) pass = k * 256 + vcu;
                    else if (vcu < 192) pass = (k == 0) ? (512 + 2 * (vcu - 160)) : vcu;
                    else pass = (k == 0) ? vcu : (k == 1) ? (416 + vcu - 192) : ((vcu < 224) ? (480 + vcu - 192) : (513 + 2 * (vcu - 224)));
                    const int tb = 2 * pass + (wave >> 2);
                    LAS float* T = tab + par * 512 + (wave >> 2) * 256 + tr * 16; const int row = tb * 16 + tr;
                    f32x4 a0[8];
                    const float s0 = pool_compute(l, tb, g, PROJ, state_pool, POOLW, a0, ln); if (kq == 0) T[g] = s0;
                    conv_quad(l, tb * 4 + g, PROJ, state_conv, conv_w, YU, ln);
                    LDS_WAIT(); __builtin_amdgcn_s_barrier(); asm volatile("" ::: "memory");
                    const float r = __builtin_amdgcn_rsqf(((T[0] + T[1]) + (T[2] + T[3])) * (1.0f / 512.0f) + EPS);
                    tile_store(a0, r, YU + (size_t)row * DM + g * 128 + 4 * kq);
                }
                }
                {
                PHASE_ENV
                const int gt = vcu * (NWAVES * 64) + tid, ngt = G * NWAVES * 64;
                for (int o = gt; o < (2 + DB) * 15 * 512; o += ngt) { const int c = o & 511, ri = o >> 9, b = ri / 15, i = ri - b * 15;
                    if (b < 2) out[O_PP + ((size_t)(l * 2 + b) * 15 + i) * 512 + c] = bf2f(PROJ[(size_t)(b * SEQ + SEQ - 15 + i) * INW + C_P + c]);
                    else out[O_PS + ((size_t)(l * DB + (b - 2)) * 15 + i) * 512 + c] = bf2f(PROJ[(size_t)(MP + (b - 2) * DSEQ + DSEQ - 15 + i) * INW + C_P + c]); }
                for (int o = gt; o < (2 + DB) * 2 * 768; o += ngt) { const int c = o % 768, ri = o / 768, b = ri >> 1, i = ri & 1;
                    const size_t row = b < 2 ? (size_t)(b * SEQ + SEQ - 2 + i) : (size_t)(MP + (b - 2) * DSEQ + DSEQ - 2 + i);
                    const float zz = bf2f(PROJ[row * INW + C_CG + c]) * bf2f(PROJ[row * INW + C_H + c]);
                    if (b < 2) out[O_CP + ((size_t)(l * 2 + b) * 2 + i) * 768 + c] = zz; else out[O_CS + ((size_t)(l * DB + (b - 2)) * 2 + i) * 768 + c] = zz; }
                GRID_BAR();
                }
            }
            if (IN(base + 6)) for (int rep = 0; rep < REPS(6); ++rep) {
                PHASE_ENV
                pg8::Gemm g{YU, (bf16*)(ws + WS_WOUT) + (size_t)l * (DM * DM), M, DM, DM}; pg8::SplitOrder S; S.init(DM, bx);
                EpiD E{D16, DSL};
                pg8::gemm_phase<EpiD, pg8::SplitOrder, GP_ALIGN, GP_SP2>(lds, g, S, E, tid);
                GRID_BAR();
            }
            if (IN(base + 7)) for (int rep = 0; rep < REPS(3); ++rep) { PHASE_ENV ew_phase(X, XB, SSX, D16, DSL, args.in[17] + (size_t)(l * 6 + 3) * DM, (rep + 1 == REPS(3)) ? 1.0f : 0.0f, false, gw, ngw, lane); GRID_BAR(); }
        }
    }
#undef IN
#undef GRID_BAR
}

#ifndef MK_ONE_LAUNCH
#define MK_ONE_LAUNCH 1
#endif
extern "C" void kernel_launch(void* const* d_in, const int* in_sizes, int n_in, void* d_out, int out_size, void* d_ws, size_t ws_size, hipStream_t stream) {
    static int grid = 0;
    if (grid == 0) {
        if (n_in != 19 || out_size != (int)O_END || ws_size < WS_END) { fprintf(stderr, "kernel_launch: unexpected shapes: n_in %d out %d ws %zu (need %zu); nothing launched\n", n_in, out_size, ws_size, (size_t)WS_END); grid = -1; return; }
        int dev = 0, cus = 0, per_cu = 0;
        if (hipGetDevice(&dev) != hipSuccess || hipDeviceGetAttribute(&cus, hipDeviceAttributeMultiprocessorCount, dev) != hipSuccess) { fprintf(stderr, "kernel_launch: device query failed\n"); grid = -1; return; }
        if (hipFuncSetAttribute((const void*)fwd, hipFuncAttributeMaxDynamicSharedMemorySize, LDS_BYTES) != hipSuccess) { fprintf(stderr, "kernel_launch: hipFuncSetAttribute failed\n"); grid = -1; return; }
        if (hipOccupancyMaxActiveBlocksPerMultiprocessor(&per_cu, (const void*)fwd, NWAVES * 64, LDS_BYTES) != hipSuccess || per_cu < 1) { fprintf(stderr, "kernel_launch: occupancy query reports %d workgroups per CU\n", per_cu); }
        (void)hipGetLastError();
        if (cus != 256) { fprintf(stderr, "kernel_launch: built for a 256-CU device (the split-K unit deal), found %d CUs; nothing launched\n", cus); grid = -1; return; }
        grid = cus;
    }
    if (grid < 0) return;
    if (hipMemsetAsync((char*)d_ws + WS_CTL, 0, CTL_ZERO_BYTES, stream) != hipSuccess) { fprintf(stderr, "kernel_launch: memset failed\n"); return; }
    Args a{};
    for (int i = 0; i < 19; ++i) a.in[i] = (const float*)d_in[i];
    a.out = (float*)d_out; a.ws = (unsigned char*)d_ws;
#if MK_ONE_LAUNCH
    a.step_lo = 0; a.step_hi = N_STEPS; a.use_bar = 1;
    hipLaunchKernelGGL(fwd, dim3(grid), dim3(NWAVES * 64), LDS_BYTES, stream, a);
#else
    for (int st = 0; st < N_STEPS; ++st) {
        if (st > 0) { const int s = (st - 1) >> 3, p = (st - 1) & 7; if (((s & 1) && p >= 3) || p == 5) continue; }
        a.step_lo = st; a.step_hi = st + 1; a.use_bar = 0;
        hipLaunchKernelGGL(fwd, dim3(grid), dim3(NWAVES * 64), LDS_BYTES, stream, a);
    }
#endif
    const hipError_t le = hipPeekAtLastError();
    if (le != hipSuccess) fprintf(stderr, "kernel_launch: launch failed: %s\n", hipGetErrorName(le));
}
```

```cpp
#include <hip/hip_runtime.h>
#include <cstdio>
#include <cstdint>
namespace pg8 {
#define PG8_LAS __attribute__((address_space(3)))
typedef unsigned short bf16_t;
typedef short bf16x8 __attribute__((ext_vector_type(8)));
typedef float f32x4 __attribute__((ext_vector_type(4)));
typedef unsigned u32x4 __attribute__((ext_vector_type(4)));
constexpr int BM = 256, BK = 64, HALF = 128, HTB = HALF * BK * 2  , STAGE_BYTES = 8 * HTB, NXCD = 8, WGM = 8;

__host__ __device__ __forceinline__ int lds_byte(int r, int c) { const int st = (r >> 4) * 2 + (c >> 5), rr = r & 15, cc = c & 31, ob = rr * 64 + cc * 2; return st * 1024 + (ob ^ (((ob >> 9) & 1) << 5)); }
__host__ __device__ __forceinline__ void stage_rc(int b, int& R, int& C) { const int st = b / 1024, sb = b % 1024, swz = sb ^ (((sb >> 9) & 1) << 5); R = (st >> 1) * 16 + swz / 64; C = (st & 1) * 32 + (swz % 64) / 2; }
__host__ __device__ __forceinline__ int perm32(int rho) { const int n = rho >> 4, i = rho & 15; return 8 * (i >> 2) + 4 * n + (i & 3); }

struct Unit { int pm, pn, kb, nt, slab; };
struct Gemm { const bf16_t* A; const bf16_t* Bt; int M, N, K; };

struct StaticOrder {
    int nM, nN, nwg, G, c, ntK, pn0;
    __host__ __device__ void init(int M, int N, int K, int G_, int c_, int pn0_ = 0) { nM = M / BM; nN = N / BM; nwg = nM * nN; G = G_; c = c_; ntK = K / BK; pn0 = pn0_; }
    __host__ __device__ bool next(int i, Unit& u) const {
        const long L = (long)i * G + c; if (L >= nwg) return false;
        int wgid = (int)L; { const int q = nwg / NXCD, r = nwg % NXCD, xcd = wgid % NXCD, off = wgid / NXCD; wgid = (xcd < r ? xcd * (q + 1) : r * (q + 1) + (xcd - r) * q) + off; }
        const int nig = WGM * nN, gid = wgid / nig, fm = gid * WGM, gsz = (nM - fm) < WGM ? (nM - fm) : WGM;
        u.pm = fm + ((wgid % nig) % gsz); u.pn = pn0 + (wgid % nig) / gsz; u.kb = 0; u.nt = ntK; u.slab = 0; return true;
    }
    __device__ __forceinline__ void a_ready(const Unit&) const {}
    __device__ __forceinline__ void done(const Unit&) const {}
};
struct SplitOrder {
    int c, ntK;
    __host__ __device__ void init(int K, int c_) { c = c_; ntK = K / BK; }
    __host__ __device__ bool next(int i, Unit& u) const {
        if (i < 2) { const int L = i * 256 + c, wgid = (L & 7) * 64 + (L >> 3), w64 = wgid & 63;
            u.pm = (wgid >> 6) * 8 + (w64 & 7); u.pn = w64 >> 3; u.kb = 0; u.nt = ntK; u.slab = 0; return true; }
        if (i == 2) { const int j = c >> 3, q = j >> 3; u.pm = 64 + (c & 7); u.pn = j & 7; u.nt = ntK >> 2; u.kb = q * u.nt; u.slab = 1 + q; return true; }
        return false;
    }
    __device__ __forceinline__ void a_ready(const Unit&) const {}
    __device__ __forceinline__ void done(const Unit&) const {}
};

__device__ __forceinline__ unsigned cvt_pk_bf16(float lo, float hi) { unsigned r; asm volatile("v_cvt_pk_bf16_f32 %0, %1, %2" : "=v"(r) : "v"(lo), "v"(hi)); return r; }
template <class Epi, class Sched, bool ALIGN_EPI = false, bool SP2 = false, bool SWAP = false>
__device__ __forceinline__ void gemm_phase(PG8_LAS unsigned char* lds, const Gemm g, const Sched& S, const Epi& E, const int tid) {
    const int wid = __builtin_amdgcn_readfirstlane(tid >> 6), lane = tid & 63, wr = wid >> 2, wc = wid & 3, fr = lane & 15, fq = lane >> 4;
    const int K = g.K;
    unsigned voffA[2], voffB[2];
#pragma unroll
    for (int i = 0; i < 2; ++i) { int R, C; stage_rc(tid * 16 + i * 8192, R, C); const int Rb = Epi::PERM ? ((R & ~31) + perm32(R & 31)) : R;
        voffA[i] = (unsigned)(R * K + C) * 2u; voffB[i] = (unsigned)(Rb * K + C) * 2u; }
    const size_t kstep = (size_t)(BK * 2);
    const size_t hstep = (size_t)HALF * K * 2;
    const size_t tstep = 2 * hstep;
    const unsigned ldsw = (unsigned)wid * 1024u;
    const int aoff = lds_byte(wr * 64 + fr, fq * 8), boff = lds_byte(wc * 32 + fr, fq * 8);
#define PG8_SA(b, h) (((b) * 2 + (h)) * HTB)
#define PG8_SB(b, h) ((4 + (b) * 2 + (h)) * HTB)
#define PG8_STAGE(bufoff, gbase, voff) do { _Pragma("unroll") for (int _i = 0; _i < 2; ++_i) \
        __builtin_amdgcn_global_load_lds((const unsigned*)((const char*)(gbase) + (voff)[_i]), (PG8_LAS unsigned*)(lds + (bufoff) + ldsw + _i * 8192), 16, 0, 0); } while (0)
#define PG8_LDA(dst, b, h) do { _Pragma("unroll") for (int m = 0; m < 4; ++m) _Pragma("unroll") for (int k = 0; k < 2; ++k) dst[m][k] = *(const PG8_LAS bf16x8*)(lds + PG8_SA(b, h) + aoff + m * 2048 + k * 1024); } while (0)
#define PG8_LDB(dst, b, h) do { _Pragma("unroll") for (int n = 0; n < 2; ++n) _Pragma("unroll") for (int k = 0; k < 2; ++k) dst[n][k] = *(const PG8_LAS bf16x8*)(lds + PG8_SB(b, h) + boff + n * 2048 + k * 1024); } while (0)
#define PG8_MMA(ai, bj, At, Bt) do { __builtin_amdgcn_s_setprio(1); _Pragma("unroll") for (int m = 0; m < 4; ++m) _Pragma("unroll") for (int n = 0; n < 2; ++n) _Pragma("unroll") for (int k = 0; k < 2; ++k) \
        acc[ai][bj][m][n] = SWAP ? __builtin_amdgcn_mfma_f32_16x16x32_bf16(At[m][k], Bt[n][k], acc[ai][bj][m][n], 0, 0, 0) : __builtin_amdgcn_mfma_f32_16x16x32_bf16(Bt[n][k], At[m][k], acc[ai][bj][m][n], 0, 0, 0); __builtin_amdgcn_s_setprio(0); } while (0)
#define PG8_MMA2(ai, bj, At, Bt, ai2, bj2, At2, Bt2) do { __builtin_amdgcn_s_setprio(1); _Pragma("unroll") for (int m = 0; m < 4; ++m) _Pragma("unroll") for (int n = 0; n < 2; ++n) _Pragma("unroll") for (int k = 0; k < 2; ++k) \
        acc[ai][bj][m][n] = SWAP ? __builtin_amdgcn_mfma_f32_16x16x32_bf16(At[m][k], Bt[n][k], acc[ai][bj][m][n], 0, 0, 0) : __builtin_amdgcn_mfma_f32_16x16x32_bf16(Bt[n][k], At[m][k], acc[ai][bj][m][n], 0, 0, 0); \
        _Pragma("unroll") for (int m = 0; m < 4; ++m) _Pragma("unroll") for (int n = 0; n < 2; ++n) _Pragma("unroll") for (int k = 0; k < 2; ++k) \
        acc[ai2][bj2][m][n] = SWAP ? __builtin_amdgcn_mfma_f32_16x16x32_bf16(At2[m][k], Bt2[n][k], acc[ai2][bj2][m][n], 0, 0, 0) : __builtin_amdgcn_mfma_f32_16x16x32_bf16(Bt2[n][k], At2[m][k], acc[ai2][bj2][m][n], 0, 0, 0); __builtin_amdgcn_s_setprio(0); } while (0)
#define PG8_WAIT_V(n) asm volatile("s_waitcnt vmcnt(" #n ")" ::: "memory")
#define PG8_WAIT_L(n) asm volatile("s_waitcnt lgkmcnt(" #n ")" ::: "memory")
#define PG8_BAR __builtin_amdgcn_s_barrier()
#define PG8_SCHED __builtin_amdgcn_sched_barrier(0)
    Unit cur, nxt; int ui = 0;
    if (!S.next(0, cur)) return;
    f32x4 acc[2][2][4][2];
#pragma unroll
    for (int a = 0; a < 2; ++a)
#pragma unroll
        for (int b = 0; b < 2; ++b)
#pragma unroll
            for (int m = 0; m < 4; ++m)
#pragma unroll
                for (int n = 0; n < 2; ++n) acc[a][b][m][n] = (f32x4){0.f, 0.f, 0.f, 0.f};
    bf16x8 At[4][2], B0[2][2], B1[2][2];
    const char* cA = (const char*)g.A + (size_t)cur.pm * tstep + (size_t)cur.kb * kstep; const char* cB = (const char*)g.Bt + (size_t)cur.pn * tstep + (size_t)cur.kb * kstep;
    S.a_ready(cur);
    if constexpr (SP2) {
        PG8_STAGE(PG8_SB(0, 0), cB, voffB); PG8_STAGE(PG8_SB(0, 1), cB + hstep, voffB); PG8_STAGE(PG8_SA(0, 0), cA, voffA); PG8_STAGE(PG8_SA(0, 1), cA + hstep, voffA);
        if (wr == 1) PG8_BAR;
        PG8_WAIT_V(2); PG8_BAR;
        PG8_STAGE(PG8_SB(1, 0), cB + kstep, voffB); PG8_STAGE(PG8_SA(1, 0), cA + kstep, voffA); PG8_STAGE(PG8_SB(1, 1), cB + hstep + kstep, voffB);
        PG8_WAIT_V(6); PG8_BAR;
    } else {
        PG8_STAGE(PG8_SB(0, 0), cB, voffB); PG8_STAGE(PG8_SA(0, 0), cA, voffA); PG8_STAGE(PG8_SB(0, 1), cB + hstep, voffB); PG8_STAGE(PG8_SA(0, 1), cA + hstep, voffA);
        if (wr == 1) PG8_BAR;
        PG8_WAIT_V(4); PG8_BAR;
        PG8_STAGE(PG8_SB(1, 0), cB + kstep, voffB); PG8_STAGE(PG8_SA(1, 0), cA + kstep, voffA); PG8_STAGE(PG8_SB(1, 1), cB + hstep + kstep, voffB);
        PG8_WAIT_V(6); PG8_BAR;
    }
    for (;;) {
        const bool has_next = S.next(ui + 1, nxt);
        const char* nA = has_next ? (const char*)g.A + (size_t)nxt.pm * tstep + (size_t)nxt.kb * kstep : cA; const char* nB = has_next ? (const char*)g.Bt + (size_t)nxt.pn * tstep + (size_t)nxt.kb * kstep : cB;
        const int nt = cur.nt;
        for (int t = 0; t < nt; t += 2) {
            const bool last = (t == nt - 2);
            const char* a1 = cA + (size_t)(t + 1) * kstep;
            const char* a2 = last ? nA : cA + (size_t)(t + 2) * kstep; const char* b2 = last ? nB : cB + (size_t)(t + 2) * kstep;
            const char* a3 = a2 + kstep; const char* b3 = b2 + kstep;
            if (last && has_next) S.a_ready(nxt);
            if constexpr (SP2) {
            PG8_LDB(B0, 0, 0); PG8_LDB(B1, 0, 1); PG8_SCHED; PG8_LDA(At, 0, 0); PG8_STAGE(PG8_SA(1, 1), a1 + hstep, voffA);
            PG8_WAIT_V(8); PG8_WAIT_L(0); PG8_BAR; PG8_MMA2(0, 0, At, B0, 0, 1, At, B1); PG8_BAR; PG8_SCHED;
            PG8_LDA(At, 0, 1); PG8_STAGE(PG8_SB(0, 0), b2, voffB); PG8_STAGE(PG8_SB(0, 1), b2 + hstep, voffB); PG8_STAGE(PG8_SA(0, 0), a2, voffA);
            PG8_WAIT_V(8); PG8_WAIT_L(0); PG8_BAR; PG8_MMA2(1, 0, At, B0, 1, 1, At, B1); PG8_BAR; PG8_SCHED;
            PG8_LDB(B0, 1, 0); PG8_LDB(B1, 1, 1); PG8_SCHED; PG8_LDA(At, 1, 0); PG8_STAGE(PG8_SA(0, 1), a2 + hstep, voffA);
            PG8_WAIT_V(8); PG8_WAIT_L(0); PG8_BAR; PG8_MMA2(0, 0, At, B0, 0, 1, At, B1); PG8_BAR; PG8_SCHED;
            PG8_LDA(At, 1, 1); PG8_STAGE(PG8_SB(1, 0), b3, voffB); PG8_STAGE(PG8_SB(1, 1), b3 + hstep, voffB); PG8_STAGE(PG8_SA(1, 0), a3, voffA);
            PG8_WAIT_V(8); PG8_WAIT_L(0); PG8_BAR; PG8_MMA2(1, 0, At, B0, 1, 1, At, B1); PG8_BAR; PG8_SCHED;
            } else {
            PG8_LDB(B0, 0, 0); PG8_SCHED; PG8_LDA(At, 0, 0); PG8_STAGE(PG8_SA(1, 1), a1 + hstep, voffA);
            PG8_WAIT_L(8); PG8_BAR; PG8_WAIT_L(0); PG8_MMA(0, 0, At, B0); PG8_BAR; PG8_SCHED;
            PG8_LDB(B1, 0, 1); PG8_STAGE(PG8_SB(0, 0), b2, voffB);
            PG8_BAR; PG8_WAIT_L(0); PG8_MMA(0, 1, At, B1); PG8_BAR;
            PG8_LDA(At, 0, 1); PG8_STAGE(PG8_SA(0, 0), a2, voffA);
            PG8_BAR; PG8_WAIT_L(0); PG8_MMA(1, 0, At, B0); PG8_BAR; PG8_SCHED;
            PG8_STAGE(PG8_SB(0, 1), b2 + hstep, voffB);
            PG8_WAIT_V(6); PG8_BAR; PG8_MMA(1, 1, At, B1); PG8_BAR;
            PG8_LDB(B0, 1, 0); PG8_SCHED; PG8_LDA(At, 1, 0); PG8_STAGE(PG8_SA(0, 1), a2 + hstep, voffA);
            PG8_WAIT_L(8); PG8_BAR; PG8_WAIT_L(0); PG8_MMA(0, 0, At, B0); PG8_BAR; PG8_SCHED;
            PG8_LDB(B1, 1, 1); PG8_STAGE(PG8_SB(1, 0), b3, voffB);
            PG8_BAR; PG8_WAIT_L(0); PG8_MMA(0, 1, At, B1); PG8_BAR;
            PG8_LDA(At, 1, 1); PG8_STAGE(PG8_SA(1, 0), a3, voffA);
            PG8_BAR; PG8_WAIT_L(0); PG8_MMA(1, 0, At, B0); PG8_BAR; PG8_SCHED;
            PG8_STAGE(PG8_SB(1, 1), b3 + hstep, voffB);
            PG8_WAIT_V(6); PG8_BAR; PG8_MMA(1, 1, At, B1); PG8_BAR;
            }
        }
        if constexpr (ALIGN_EPI) { if (wr == 0) PG8_BAR; }
        if constexpr (!Epi::AFTER_DRAIN) { E(acc, cur, wr, wc, fr, fq); S.done(cur); }
        if (!has_next) break;
#pragma unroll
        for (int a = 0; a < 2; ++a)
#pragma unroll
            for (int b = 0; b < 2; ++b)
#pragma unroll
                for (int m = 0; m < 4; ++m)
#pragma unroll
                    for (int n = 0; n < 2; ++n) acc[a][b][m][n] = (f32x4){0.f, 0.f, 0.f, 0.f};
        cur = nxt; cA = nA; cB = nB; ++ui;
        if constexpr (ALIGN_EPI) { if (wr == 1) PG8_BAR; }
    }
    PG8_WAIT_V(0);
    if constexpr (!ALIGN_EPI) { if (wr == 0) PG8_BAR; }
    PG8_BAR;
    if constexpr (Epi::AFTER_DRAIN) { E.fused(acc, cur, wr, wc, fr, fq, lds, wid, lane); S.done(cur); }
#undef PG8_SA
#undef PG8_SB
#undef PG8_STAGE
#undef PG8_LDA
#undef PG8_LDB
#undef PG8_MMA
#undef PG8_MMA2
#undef PG8_WAIT_V
#undef PG8_WAIT_L
#undef PG8_BAR
#undef PG8_SCHED
}
}
#define GAS __attribute__((address_space(1)))
#define LAS __attribute__((address_space(3)))
typedef unsigned short bf16;
typedef unsigned v4u __attribute__((ext_vector_type(4)));
typedef float f32x4 __attribute__((ext_vector_type(4)));
typedef short bf16x8 __attribute__((ext_vector_type(8)));
typedef GAS unsigned gu32;
typedef GAS unsigned long long gu64;
#define RLX_AGENT __ATOMIC_RELAXED, __HIP_MEMORY_SCOPE_AGENT
#define LDS_WAIT() asm volatile("s_waitcnt lgkmcnt(0)" ::: "memory")
#define VM_WAIT() asm volatile("s_waitcnt vmcnt(0)" ::: "memory")
__device__ __forceinline__ unsigned long long rt() { return __builtin_amdgcn_s_memrealtime(); }
__device__ __forceinline__ unsigned f2bf(float f) { unsigned u = __builtin_bit_cast(unsigned, f); return (u + 0x7fffu + ((u >> 16) & 1u)) >> 16; }
__device__ __forceinline__ unsigned pk2(float lo, float hi) { return f2bf(lo) | (f2bf(hi) << 16); }

#define XB_TMO      128
#define XB_XCNT(j)  (256  + 64 * (j))
#define XB_XSUB(j)  (1280 + 64 * (j))
#define XB_XGEN(j)  (2304 + 64 * (j))
#define XB_TOP      3328
#define XB_TOPGEN   3392
#define XCD_BAR_WORDS 3456
#define XB_SPIN_CAP (1u << 18)

__device__ __forceinline__ unsigned xb_ld(unsigned* p)              { return __hip_atomic_load(p, __ATOMIC_RELAXED, __HIP_MEMORY_SCOPE_AGENT); }
__device__ __forceinline__ unsigned xb_add(unsigned* p, unsigned v) { return __hip_atomic_fetch_add(p, v, __ATOMIC_RELAXED, __HIP_MEMORY_SCOPE_AGENT); }
__device__ __forceinline__ unsigned xb_xcc_id() { return (unsigned)__builtin_amdgcn_s_getreg((3 << 11) | 20) & 0xFu; }
#define XB_SPIN(cond, bar) do { unsigned _sp = 0; while (cond) { __builtin_amdgcn_s_sleep(1); \
    if ((++_sp & 255u) == 0u) { if (xb_ld(&(bar)[XB_TMO])) break; if (_sp > XB_SPIN_CAP) { atomicAdd(&(bar)[XB_TMO], 1u); break; } } } } while (0)

struct XcdBarrier {
    unsigned* bar; unsigned x;
    volatile LAS unsigned* st;
};

__device__ __forceinline__ XcdBarrier xcd_barrier_post(unsigned* bar, volatile LAS unsigned* st) {
    XcdBarrier b; b.bar = bar; b.x = xb_xcc_id(); b.st = st;
    if (threadIdx.x == 0) (void)xb_add(&bar[XB_XCNT(b.x)], 1u);
    return b;
}
__device__ __forceinline__ void xcd_barrier_complete(unsigned* bar, unsigned x, unsigned& nloc, unsigned& nx) {
    const unsigned G = gridDim.x * gridDim.y * gridDim.z;
    unsigned sum, cnt, mine, sp = 0u;
    for (;;) {
        sum = 0u; cnt = 0u; mine = 0u;
#pragma unroll
        for (unsigned j = 0; j < 16; ++j) { const unsigned c = xb_ld(&bar[XB_XCNT(j)]); sum += c; cnt += (c > 0u) ? 1u : 0u; mine = (j == x) ? c : mine; }
        if (sum == G) break;
        __builtin_amdgcn_s_sleep(1);
        if ((++sp & 255u) == 0u) { if (xb_ld(&bar[XB_TMO])) break; if (sp > XB_SPIN_CAP) { atomicAdd(&bar[XB_TMO], 1u); break; } }
    }
    nloc = mine > 0u ? mine : 1u; nx = cnt > 0u ? cnt : 1u;
}

__device__ __forceinline__ void xcd_barrier(const XcdBarrier& b, const bool t0  ) {
    asm volatile("s_waitcnt vmcnt(0)" ::: "memory");
    __syncthreads();
    if (t0) {
        unsigned* bar = b.bar;
        __builtin_amdgcn_s_waitcnt(0);
        unsigned nloc = b.st[0], nx = b.st[1];
        if (nloc == 0u) { xcd_barrier_complete(bar, b.x, nloc, nx); b.st[0] = nloc; b.st[1] = nx; }
        const unsigned old = xb_add(&bar[XB_XSUB(b.x)], 1u);
        const unsigned gen = old / nloc;
        if (old + 1u == (gen + 1u) * nloc) {
            __builtin_amdgcn_fence(__ATOMIC_RELEASE, "agent");
            asm volatile("s_waitcnt vmcnt(0)" ::: "memory");
            const unsigned og = xb_add(&bar[XB_TOP], 1u);
            const unsigned tg = og / nx;
            if (og + 1u == (tg + 1u) * nx) xb_add(&bar[XB_TOPGEN], 1u);
            else XB_SPIN(xb_ld(&bar[XB_TOPGEN]) == tg, bar);
            __builtin_amdgcn_fence(__ATOMIC_ACQUIRE, "agent");
            xb_add(&bar[XB_XGEN(b.x)], 1u);
            asm volatile("s_waitcnt vmcnt(0)" ::: "memory");
        } else {
            XB_SPIN(xb_ld(&bar[XB_XGEN(b.x)]) == gen, bar);
            __builtin_amdgcn_fence(__ATOMIC_ACQUIRE, "agent");
            asm volatile("s_waitcnt vmcnt(0)" ::: "memory");
        }
    }
    __syncthreads();
}

constexpr int DM = 2048, DFF = 5632, INW = 4352, NLAYER = 4;
constexpr int SEQ = 8192, MP = 2 * SEQ, DSEQ = 64, DB = 32, MS = DB * DSEQ, M = MP + MS;
constexpr int C_P = 0, C_H = 512, C_BG = 1280, C_CG = 2048, C_U = 2816, C_V = 3584;
constexpr float EPS = 1e-6f;
constexpr int NWAVES = 8;
constexpr size_t O_YP = 0, O_YS = (size_t)MP * DM, O_PP = (size_t)M * DM, O_CP = O_PP + (size_t)NLAYER * 2 * 15 * 512, O_PS = O_CP + (size_t)NLAYER * 2 * 2 * 768,
                 O_CS = O_PS + (size_t)NLAYER * DB * 15 * 512, O_VS = O_CS + (size_t)NLAYER * DB * 2 * 768, O_END = O_VS + (size_t)NLAYER * DB * DSEQ * 768;
static_assert(O_END == 45293568, "d_out map");
constexpr size_t WS_CTL = 0, CTL_ZERO_BYTES = 1u << 20;
constexpr size_t SZ_WGU = (size_t)2 * DFF * DM * 2, SZ_WD = (size_t)DM * DFF * 2, SZ_WIN = (size_t)INW * DM * 2, SZ_WOUT = (size_t)DM * DM * 2, SZ_POOLW = (size_t)4 * 128 * 128 * 2, SZ_SGUW = (size_t)6 * 128 * 128 * 2;
constexpr size_t WS_WGU = 1u << 20, WS_WD = WS_WGU + 8 * SZ_WGU, WS_WIN = WS_WD + 8 * SZ_WD, WS_WOUT = WS_WIN + 4 * SZ_WIN, WS_POOLW = WS_WOUT + 4 * SZ_WOUT, WS_SGUW = WS_POOLW + 4 * SZ_POOLW;
constexpr size_t WS_XB = WS_SGUW + 4 * SZ_SGUW, WS_H = WS_XB + (size_t)M * DM * 2, WS_D = WS_H + (size_t)M * DFF * 2, WS_DSL = WS_D + (size_t)MP * DM * 2, WS_YU = WS_DSL + (size_t)4 * MS * DM * 4;
constexpr size_t WS_SSX = WS_YU + (size_t)M * DM * 2, WS_GS = WS_SSX + (size_t)M * 4, WS_VT = WS_GS + (size_t)M * 16 * 4, WS_END = WS_VT + (size_t)M * 768 * 2;
static_assert(WS_END <= 1475633152ull, "d_ws map exceeds the guaranteed workspace");
static_assert(WS_XB % 256 == 0 && WS_H % 256 == 0 && WS_D % 256 == 0 && WS_YU % 256 == 0 && WS_SSX % 256 == 0 && WS_DSL % 256 == 0 && WS_GS % 256 == 0, "alignment");
constexpr int CW_BAR = 4096;
constexpr int RING_BYTES = 131072, MISC_OFF = RING_BYTES, LDS_BYTES = RING_BYTES + 1024;

typedef unsigned u32x2 __attribute__((ext_vector_type(2)));
__device__ __forceinline__ float bf2f(unsigned short b) { return __builtin_bit_cast(float, (unsigned)b << 16); }
__device__ __forceinline__ float shx(float v, int o, int lane) { return __builtin_bit_cast(float, __builtin_amdgcn_ds_bpermute((lane ^ o) << 2, __builtin_bit_cast(int, v))); }
__device__ __forceinline__ float wave_sum(float v, int lane) {
#pragma unroll
    for (int o = 1; o < 64; o <<= 1) v += shx(v, o, lane);
    return v;
}
__device__ __forceinline__ void unpack8(bf16x8 v, float (&f)[8]) {
#pragma unroll
    for (int i = 0; i < 8; ++i) f[i] = bf2f((unsigned short)v[i]);
}
__device__ __forceinline__ void unpack4(u32x2 v, float (&f)[4]) {
    f[0] = __builtin_bit_cast(float, v.x << 16); f[1] = __builtin_bit_cast(float, v.x & 0xffff0000u);
    f[2] = __builtin_bit_cast(float, v.y << 16); f[3] = __builtin_bit_cast(float, v.y & 0xffff0000u);
}

struct EpiGateUp {
    static constexpr bool PERM = true, AFTER_DRAIN = false;
    bf16* H; const float* ssx;
    __device__ __forceinline__ void operator()(const pg8::f32x4 (&acc)[2][2][4][2], const pg8::Unit& u, int wr, int wc, int fr, int fq) const {
        const int row0 = u.pm * 256 + wr * 64 + fr, col0 = u.pn * 128 + wc * 32 + 8 * fq;
        float rs[2][4];
#pragma unroll
        for (int ai = 0; ai < 2; ++ai)
#pragma unroll
            for (int m = 0; m < 4; ++m) rs[ai][m] = ssx[row0 + ai * 128 + m * 16];
#pragma unroll
        for (int ai = 0; ai < 2; ++ai)
#pragma unroll
            for (int mp = 0; mp < 2; ++mp) {
                float g[16], uu[16], t[16];
#pragma unroll
                for (int mm = 0; mm < 2; ++mm) { const int m = 2 * mp + mm; const float r = __builtin_amdgcn_rsqf(rs[ai][m] * (1.0f / DM) + EPS);
#pragma unroll
                    for (int n = 0; n < 2; ++n)
#pragma unroll
                        for (int e = 0; e < 4; ++e) { g[8 * mm + 4 * n + e] = acc[ai][0][m][n][e] * r; uu[8 * mm + 4 * n + e] = acc[ai][1][m][n][e] * r; } }
#pragma unroll
                for (int i = 0; i < 16; ++i) t[i] = g[i] * -1.44269504f;
#pragma unroll
                for (int i = 0; i < 16; ++i) t[i] = __builtin_amdgcn_exp2f(t[i]);
#pragma unroll
                for (int i = 0; i < 16; ++i) t[i] = 1.0f + t[i];
#pragma unroll
                for (int i = 0; i < 16; ++i) t[i] = __builtin_amdgcn_rcpf(t[i]);
#pragma unroll
                for (int i = 0; i < 16; ++i) g[i] = g[i] * uu[i];
#pragma unroll
                for (int i = 0; i < 16; ++i) g[i] = g[i] * t[i];
#pragma unroll
                for (int mm = 0; mm < 2; ++mm) { const int row = row0 + ai * 128 + (2 * mp + mm) * 16; const float* hv = g + 8 * mm;
                    v4u w; w.x = pg8::cvt_pk_bf16(hv[0], hv[1]); w.y = pg8::cvt_pk_bf16(hv[2], hv[3]); w.z = pg8::cvt_pk_bf16(hv[4], hv[5]); w.w = pg8::cvt_pk_bf16(hv[6], hv[7]);
                    *(v4u*)(H + (size_t)row * DFF + col0) = w; }
            }
    }
};
struct EpiProj {
    static constexpr bool PERM = true, AFTER_DRAIN = false;
    bf16* P; const float* ssx;
    __device__ __forceinline__ void operator()(const pg8::f32x4 (&acc)[2][2][4][2], const pg8::Unit& u, int wr, int wc, int fr, int fq) const {
        const int row0 = u.pm * 256 + wr * 64 + fr, col0 = u.pn * 256 + wc * 32 + 8 * fq;
        float rs[2][4];
#pragma unroll
        for (int ai = 0; ai < 2; ++ai)
#pragma unroll
            for (int m = 0; m < 4; ++m) rs[ai][m] = ssx[row0 + ai * 128 + m * 16];
#pragma unroll
        for (int ai = 0; ai < 2; ++ai)
#pragma unroll
            for (int m = 0; m < 4; ++m) {
                const int row = row0 + ai * 128 + m * 16;
                const float r = __builtin_amdgcn_rsqf(rs[ai][m] * (1.0f / DM) + EPS);
#pragma unroll
                for (int bj = 0; bj < 2; ++bj) { const pg8::f32x4 v0 = acc[ai][bj][m][0] * r, v1 = acc[ai][bj][m][1] * r;
                    v4u w; w.x = pg8::cvt_pk_bf16(v0[0], v0[1]); w.y = pg8::cvt_pk_bf16(v0[2], v0[3]); w.z = pg8::cvt_pk_bf16(v1[0], v1[1]); w.w = pg8::cvt_pk_bf16(v1[2], v1[3]);
                    *(v4u*)(P + (size_t)row * INW + col0 + bj * 128) = w; }
            }
    }
};
struct EpiVT {
    static constexpr bool PERM = false, AFTER_DRAIN = false;
    bf16* VT; const float* ssx; float* vs;
    __device__ __forceinline__ void operator()(const pg8::f32x4 (&acc)[2][2][4][2], const pg8::Unit& u, int wr, int wc, int fr, int fq) const {
        const int rowb = u.pm * 256 + wr * 64 + 4 * fq, cb = u.pn * 256 - C_V + wc * 32 + fr;
        pg8::f32x4 rs[2][4];
#pragma unroll
        for (int ai = 0; ai < 2; ++ai)
#pragma unroll
            for (int m = 0; m < 4; ++m) rs[ai][m] = *(const pg8::f32x4*)(ssx + rowb + ai * 128 + m * 16);
#pragma unroll
        for (int ai = 0; ai < 2; ++ai)
#pragma unroll
            for (int m = 0; m < 4; ++m) {
                const int row = rowb + ai * 128 + m * 16;
                pg8::f32x4 r;
#pragma unroll
                for (int e = 0; e < 4; ++e) r[e] = __builtin_amdgcn_rsqf(rs[ai][m][e] * (1.0f / DM) + EPS);
#pragma unroll
                for (int bj = 0; bj < 2; ++bj)
#pragma unroll
                    for (int n = 0; n < 2; ++n) { const int c = cb + bj * 128 + n * 16; const pg8::f32x4 v = acc[ai][bj][m][n] * r;
                        u32x2 w; w.x = pg8::cvt_pk_bf16(v[0], v[1]); w.y = pg8::cvt_pk_bf16(v[2], v[3]);
                        *(u32x2*)(VT + ((size_t)(row >> 6) * 768 + c) * 64 + (row & 63)) = w;
                        if (row >= MP) { float* o = vs + (size_t)(row - MP) * 768 + c; o[0] = v[0]; o[768] = v[1]; o[2 * 768] = v[2]; o[3 * 768] = v[3]; } }
            }
    }
};
struct EpiD {
    static constexpr bool PERM = true, AFTER_DRAIN = false;
    bf16* D16; float* DSL;
    __device__ __forceinline__ void operator()(const pg8::f32x4 (&acc)[2][2][4][2], const pg8::Unit& u, int wr, int wc, int fr, int fq) const {
        const int row0 = u.pm * 256 + wr * 64 + fr, col0 = u.pn * 256 + wc * 32 + 8 * fq;
        if (u.slab == 0) {
#pragma unroll
            for (int ai = 0; ai < 2; ++ai)
#pragma unroll
                for (int m = 0; m < 4; ++m) { bf16* rowp = D16 + (size_t)(row0 + ai * 128 + m * 16) * DM + col0;
#pragma unroll
                    for (int bj = 0; bj < 2; ++bj) { const pg8::f32x4 v0 = acc[ai][bj][m][0], v1 = acc[ai][bj][m][1];
                        v4u w; w.x = pg8::cvt_pk_bf16(v0[0], v0[1]); w.y = pg8::cvt_pk_bf16(v0[2], v0[3]); w.z = pg8::cvt_pk_bf16(v1[0], v1[1]); w.w = pg8::cvt_pk_bf16(v1[2], v1[3]);
                        *(v4u*)(rowp + bj * 128) = w; } }
        } else {
            float* base = DSL + (size_t)(u.slab - 1) * MS * DM;
#pragma unroll
            for (int ai = 0; ai < 2; ++ai)
#pragma unroll
                for (int m = 0; m < 4; ++m) { float* rowp = base + (size_t)(row0 + ai * 128 + m * 16 - MP) * DM + col0;
#pragma unroll
                    for (int bj = 0; bj < 2; ++bj) { *(pg8::f32x4*)(rowp + bj * 128) = acc[ai][bj][m][0]; *(pg8::f32x4*)(rowp + bj * 128 + 4) = acc[ai][bj][m][1]; } }
        }
    }
};

__device__ __forceinline__ void cvt_item(const float* W, int K, int N, const float* gain, bf16* WT, int sh, int add, LAS unsigned char* scr, int item, int lane) {
    const int nblk2 = N >> 8, q = item >> 3, r8 = item & 7, qk = q / nblk2, kb = 4 * qk + (r8 >> 1), nb = 2 * (q - qk * nblk2) + (r8 & 1), k0 = kb << 6, n00 = nb << 7;
    const int kq = lane >> 4, nq = lane & 15;
    const float* src = W + (size_t)(k0 + 16 * kq) * N + n00 + 4 * nq;
    f32x4 v[2][16];
#pragma unroll
    for (int i = 0; i < 16; ++i) { v[0][i] = __builtin_nontemporal_load((const f32x4*)(src + (size_t)i * N)); v[1][i] = __builtin_nontemporal_load((const f32x4*)(src + (size_t)i * N + 64)); }
    f32x4 g4[4];
    if (gain) { const f32x4* gp = (const f32x4*)(gain + k0 + 16 * kq);
#pragma unroll
        for (int i4 = 0; i4 < 4; ++i4) g4[i4] = gp[i4]; }
    else {
#pragma unroll
        for (int i4 = 0; i4 < 4; ++i4) g4[i4] = (f32x4){1.f, 1.f, 1.f, 1.f}; }
    const int r = lane >> 3, c8 = lane & 7;
#pragma unroll
    for (int hf = 0; hf < 2; ++hf) {
        const int n0 = n00 + 64 * hf;
#pragma unroll
        for (int c = 0; c < 4; ++c) {
            float t[16];
#pragma unroll
            for (int i = 0; i < 16; ++i) t[i] = v[hf][i][c] * g4[i >> 2][i & 3];
            v4u lo, hi;
            lo.x = pg8::cvt_pk_bf16(t[0], t[1]); lo.y = pg8::cvt_pk_bf16(t[2], t[3]); lo.z = pg8::cvt_pk_bf16(t[4], t[5]); lo.w = pg8::cvt_pk_bf16(t[6], t[7]);
            hi.x = pg8::cvt_pk_bf16(t[8], t[9]); hi.y = pg8::cvt_pk_bf16(t[10], t[11]); hi.z = pg8::cvt_pk_bf16(t[12], t[13]); hi.w = pg8::cvt_pk_bf16(t[14], t[15]);
            LAS unsigned char* p = scr + (4 * nq + c) * 144 + 32 * kq;
            *(LAS v4u*)p = lo; *(LAS v4u*)(p + 16) = hi;
        }
        LDS_WAIT(); asm volatile("" ::: "memory");
#pragma unroll
        for (int j = 0; j < 8; ++j) { const int n = 8 * j + r; const v4u o = *(const LAS v4u*)(scr + n * 144 + 16 * c8);
            const int nn = n0 + n, orow = ((nn >> 7) << sh) + add + (nn & 127);
            *(v4u*)(WT + (size_t)orow * K + k0 + 8 * c8) = o; }
        LDS_WAIT(); asm volatile("" ::: "memory");
    }
}

__device__ __forceinline__ void ew_phase(float* Y, bf16* XB, float* SSX, const bf16* D16, const float* DSL, const float* gain, float alpha, bool last, int gw, int ngw, int lane) {
    for (int row = gw; row < M; row += ngw) {
        f32x4 dv[8];
        if (row < MP) { const u32x2* dr = (const u32x2*)(D16 + (size_t)row * DM) + lane;
#pragma unroll
            for (int j = 0; j < 8; ++j) { float t[4]; unpack4(dr[64 * j], t); dv[j] = (f32x4){t[0], t[1], t[2], t[3]}; } }
        else { const f32x4* dr = (const f32x4*)(DSL + (size_t)(row - MP) * DM) + lane;
#pragma unroll
            for (int j = 0; j < 8; ++j) dv[j] = (dr[64 * j] + dr[64 * j + (size_t)MS * DM / 4]) + (dr[64 * j + (size_t)2 * MS * DM / 4] + dr[64 * j + (size_t)3 * MS * DM / 4]); }
        const f32x4* gr = (const f32x4*)gain + lane; u32x2* xb = (u32x2*)(XB + (size_t)row * DM) + lane;
        f32x4 xv[8]; float sd = 0.f;
#pragma unroll
        for (int j = 0; j < 8; ++j) { float t[4]; unpack4(xb[64 * j], t); xv[j] = (f32x4){t[0], t[1], t[2], t[3]}; const f32x4 d = dv[j]; sd += (d[0] * d[0] + d[1] * d[1]) + (d[2] * d[2] + d[3] * d[3]); }
        sd = wave_sum(sd, lane);
        const float sc = __builtin_amdgcn_rsqf(sd * (1.0f / DM) + EPS) * alpha;
        float ss = 0.f;
        if (!last) {
#pragma unroll
            for (int j = 0; j < 8; ++j) { const f32x4 g = gr[64 * j]; const f32x4 x = xv[j] + dv[j] * g * sc;
                u32x2 w; w.x = pg8::cvt_pk_bf16(x[0], x[1]); w.y = pg8::cvt_pk_bf16(x[2], x[3]); xb[64 * j] = w; ss += (x[0] * x[0] + x[1] * x[1]) + (x[2] * x[2] + x[3] * x[3]); }
            ss = wave_sum(ss, lane); if (lane == 0) SSX[row] = ss;
        } else { f32x4* yr = (f32x4*)(Y + (size_t)row * DM) + lane;
#pragma unroll
            for (int j = 0; j < 8; ++j) { const f32x4 g = gr[64 * j]; yr[64 * j] = xv[j] + dv[j] * g * sc; } }
    }
}

template <int W>
__device__ __forceinline__ bf16x8 pool_frag_fast(const bf16* ub  , int loff  ) {
    bf16x8 q[W];
#pragma unroll
    for (int jj = 0; jj < W; ++jj) q[jj] = *(const bf16x8*)(ub - (size_t)jj * INW + loff);
    float s[8], p0[8]; unpack8(q[0], p0);
#pragma unroll
    for (int i = 0; i < 8; ++i) s[i] = p0[i];
#pragma unroll
    for (int jj = 1; jj < W; ++jj) { float v[8]; unpack8(q[jj], v);
#pragma unroll
        for (int i = 0; i < 8; ++i) s[i] += v[i]; }
    bf16x8 d;
#pragma unroll
    for (int i = 0; i < 8; ++i) d[i] = (short)f2bf(s[i] * (1.0f / W) - p0[i]);
    return d;
}
template <int W>
__device__ __forceinline__ bf16x8 pool_frag_first(const bf16* ub  , const float* hb  , bool samp, int tr, int kq) {
    bf16x8 q[W];
#pragma unroll
    for (int jj = 0; jj < W; ++jj) { const int tt = tr - jj; q[jj] = *(const bf16x8*)(ub + (tt < 0 ? 0 : tt) * INW + 8 * kq); }
    float s[8], p0[8]; unpack8(q[0], p0);
#pragma unroll
    for (int i = 0; i < 8; ++i) s[i] = p0[i];
#pragma unroll
    for (int jj = 1; jj < W; ++jj) { float v[8]; unpack8(q[jj], v); const bool ok = tr >= jj;
#pragma unroll
        for (int i = 0; i < 8; ++i) s[i] += ok ? v[i] : 0.f; }
    float invc = 1.0f / (float)((tr + 1) < W ? (tr + 1) : W);
    if (samp) {
        constexpr int GRP = 5;
#pragma unroll
        for (int j0 = 1; j0 < W; j0 += GRP) {
            __builtin_amdgcn_sched_barrier(0);
            f32x4 ha[GRP], hc[GRP];
#pragma unroll
            for (int k = 0; k < GRP; ++k) if (j0 + k < W) { const int hr = 15 + tr - (j0 + k); const float* hp = hb + (hr > 14 ? 14 : hr) * 512 + 8 * kq; ha[k] = *(const f32x4*)hp; hc[k] = *(const f32x4*)(hp + 4); }
#pragma unroll
            for (int k = 0; k < GRP; ++k) if (j0 + k < W) { const bool use = tr < j0 + k;
#pragma unroll
                for (int i = 0; i < 4; ++i) { s[i] += use ? ha[k][i] : 0.f; s[4 + i] += use ? hc[k][i] : 0.f; } }
        }
        invc = 1.0f / (float)W;
    }
    bf16x8 d;
#pragma unroll
    for (int i = 0; i < 8; ++i) d[i] = (short)f2bf(s[i] * invc - p0[i]);
    return d;
}
__device__ __forceinline__ float pool_compute(int l, int tb, int g, const bf16* PROJ, const float* state_pool, const bf16* POOLW, f32x4 (&acc)[8], int lane) {
    asm volatile("" : "+v"(lane));
    const int r0 = tb * 16, tr = lane & 15, kq = lane >> 4;
    const bool samp = r0 >= MP;
    int seq0, tloc0, sb = 0;
    if (!samp) { seq0 = r0 & ~(SEQ - 1); tloc0 = r0 & (SEQ - 1); } else { sb = (r0 - MP) >> 6; seq0 = MP + (sb << 6); tloc0 = (r0 - MP) & 63; }
    bf16x8 dfr[4];
    const bf16* pb = PROJ + (size_t)(seq0 + tloc0) * INW + C_P + g * 128;
    const int loff = tr * INW + 8 * kq;
    if (tloc0 == 0) {
        const float* hb = state_pool + (size_t)(l * DB + sb) * 15 * 512 + g * 128;
#pragma unroll
        for (int kt = 0; kt < 4; ++kt) {
            if (g == 0) dfr[kt] = pool_frag_first<2>(pb + 32 * kt, hb + 32 * kt, samp, tr, kq);
            else if (g == 1) dfr[kt] = pool_frag_first<4>(pb + 32 * kt, hb + 32 * kt, samp, tr, kq);
            else if (g == 2) dfr[kt] = pool_frag_first<8>(pb + 32 * kt, hb + 32 * kt, samp, tr, kq);
            else dfr[kt] = pool_frag_first<16>(pb + 32 * kt, hb + 32 * kt, samp, tr, kq);
            __builtin_amdgcn_sched_barrier(0);
        }
    } else if (g == 0) {
#pragma unroll
        for (int kt = 0; kt < 4; ++kt) dfr[kt] = pool_frag_fast<2>(pb + 32 * kt, loff);
    } else if (g == 1) {
#pragma unroll
        for (int kt = 0; kt < 4; ++kt) dfr[kt] = pool_frag_fast<4>(pb + 32 * kt, loff);
    } else if (g == 2) {
#pragma unroll
        for (int kt = 0; kt < 4; ++kt) dfr[kt] = pool_frag_fast<8>(pb + 32 * kt, loff);
    } else {
#pragma unroll
        for (int kt = 0; kt < 4; ++kt) { dfr[kt] = pool_frag_fast<16>(pb + 32 * kt, loff); if (kt == 1) __builtin_amdgcn_sched_barrier(0); }
    }
#pragma unroll
    for (int dt = 0; dt < 8; ++dt) acc[dt] = (f32x4){0.f, 0.f, 0.f, 0.f};
    const bf16* Wg = POOLW + (size_t)(l * 4 + g) * 128 * 128; const int woff = tr * 128 + 8 * kq;
    bf16x8 wf[4][8];
#pragma unroll
    for (int kt = 0; kt < 4; ++kt)
#pragma unroll
        for (int dt = 0; dt < 8; ++dt) wf[kt][dt] = *(const bf16x8*)(Wg + (16 * dt) * 128 + 32 * kt + woff);
    __builtin_amdgcn_sched_barrier(0);
#pragma unroll
    for (int kt = 0; kt < 4; ++kt)
#pragma unroll
        for (int dt = 0; dt < 8; ++dt) acc[dt] = __builtin_amdgcn_mfma_f32_16x16x32_bf16(wf[kt][dt], dfr[kt], acc[dt], 0, 0, 0);
    __builtin_amdgcn_sched_barrier(0);
    float ss = 0.f;
#pragma unroll
    for (int dt = 0; dt < 8; ++dt) { const f32x4 a = acc[dt]; ss += (a[0] * a[0] + a[1] * a[1]) + (a[2] * a[2] + a[3] * a[3]); }
    ss += shx(ss, 16, lane); ss += shx(ss, 32, lane);
    return ss;
}
__device__ __forceinline__ void tile_store(const f32x4 (&v)[8], float r, bf16* dst  ) {
#pragma unroll
    for (int dt = 0; dt < 8; ++dt) { const f32x4 a = v[dt] * r; u32x2 o; o.x = pg8::cvt_pk_bf16(a[0], a[1]); o.y = pg8::cvt_pk_bf16(a[2], a[3]); *(u32x2*)(dst + 16 * dt) = o; }
}
__device__ __forceinline__ void conv_z(int l, int seq0, int tt, bool samp, int sb, int c, const bf16* PROJ, const float* state_conv, float (&z)[4]) {
    if (tt >= 0) { float h[4], cg[4]; unpack4(*(const u32x2*)(PROJ + (size_t)(seq0 + tt) * INW + C_H + c), h); unpack4(*(const u32x2*)(PROJ + (size_t)(seq0 + tt) * INW + C_CG + c), cg);
#pragma unroll
        for (int i = 0; i < 4; ++i) z[i] = cg[i] * h[i]; }
    else if (samp) { const f32x4 a = *(const f32x4*)(state_conv + ((size_t)(l * DB + sb) * 2 + 2 + tt) * 768 + c); z[0] = a[0]; z[1] = a[1]; z[2] = a[2]; z[3] = a[3]; }
    else { z[0] = 0.f; z[1] = 0.f; z[2] = 0.f; z[3] = 0.f; }
}
__device__ __forceinline__ void conv_quad(int l, int q, const bf16* PROJ, const float* state_conv, const float* conv_w, bf16* YU, int lane) {
    asm volatile("" : "+v"(lane));
    const int row0 = 4 * q; const bool samp = row0 >= MP; int seq0, tloc0, sb = 0;
    if (!samp) { seq0 = row0 & ~(SEQ - 1); tloc0 = row0 & (SEQ - 1); } else { sb = (row0 - MP) >> 6; seq0 = MP + (sb << 6); tloc0 = (row0 - MP) & 63; }
    float ss[4] = {0.f, 0.f, 0.f, 0.f}; float y[3][4][4];
#pragma unroll
    for (int j = 0; j < 3; ++j) {
        const int c = 256 * j + 4 * lane;
        float zz[6][4];
#pragma unroll
        for (int k = 0; k < 6; ++k) conv_z(l, seq0, tloc0 - 2 + k, samp, sb, c, PROJ, state_conv, zz[k]);
        u32x2 bgr[4];
#pragma unroll
        for (int i = 0; i < 4; ++i) bgr[i] = *(const u32x2*)(PROJ + (size_t)(row0 + i) * INW + C_BG + c);
        const f32x4 w0 = *(const f32x4*)(conv_w + (size_t)(l * 3 + 0) * 768 + c), w1 = *(const f32x4*)(conv_w + (size_t)(l * 3 + 1) * 768 + c), w2 = *(const f32x4*)(conv_w + (size_t)(l * 3 + 2) * 768 + c);
#pragma unroll
        for (int i = 0; i < 4; ++i) { float bg[4]; unpack4(bgr[i], bg);
#pragma unroll
            for (int e = 0; e < 4; ++e) { const float v = bg[e] * (zz[i][e] * w0[e] + zz[i + 1][e] * w1[e] + zz[i + 2][e] * w2[e]); y[j][i][e] = v; ss[i] += v * v; } }
    }
#pragma unroll
    for (int i = 0; i < 4; ++i) { const float r = __builtin_amdgcn_rsqf(wave_sum(ss[i], lane) * (1.0f / 768.0f) + EPS);
#pragma unroll
        for (int j = 0; j < 3; ++j) { u32x2 o; o.x = pg8::cvt_pk_bf16(y[j][i][0] * r, y[j][i][1] * r); o.y = pg8::cvt_pk_bf16(y[j][i][2] * r, y[j][i][3] * r);
            *(u32x2*)(YU + (size_t)(row0 + i) * DM + 512 + 256 * j + 4 * lane) = o; } }
}
__device__ __forceinline__ float sgu_compute(int l, int tb, int h, const bf16* PROJ, const bf16* VT, const bf16* SGUW, const float* sgu_b, f32x4 (&acc)[8], int lane) {
    asm volatile("" : "+v"(lane));
    const int r0 = tb * 16, tr = lane & 15, kq = lane >> 4;
    const bool samp = r0 >= MP;
    const int chunk0 = samp ? (MP + ((r0 - MP) & ~63)) : (r0 & ~127), s0 = r0 - chunk0;
    const int nkk = samp ? 2 : 4;
    const int row = r0 + tr;
    u32x2 uraw[8];
#pragma unroll
    for (int ct = 0; ct < 8; ++ct) uraw[ct] = *(const u32x2*)(PROJ + (size_t)row * INW + C_U + h * 128 + 16 * ct + 4 * kq);
    const float bias = sgu_b[(size_t)(l * 6 + h) * 128 + s0 + tr];
#pragma unroll
    for (int ct = 0; ct < 8; ++ct) acc[ct] = (f32x4){0.f, 0.f, 0.f, 0.f};
    const bf16* Wrow = SGUW + ((size_t)(l * 6 + h) * 128 + s0) * 128; const int woff = tr * 128 + 8 * kq;
    const bf16* Vb = VT + ((size_t)(chunk0 >> 6) * 768 + h * 128) * 64; const int voff = tr * 64 + 8 * kq;
    bf16x8 wf[4], vf[4][8];
#pragma unroll
    for (int kt = 0; kt < 4; ++kt) if (kt < nkk) {
        wf[kt] = *(const bf16x8*)(Wrow + 32 * kt + woff);
        const bf16* vp = Vb + (size_t)(kt >> 1) * 768 * 64 + 32 * (kt & 1);
#pragma unroll
        for (int ct = 0; ct < 8; ++ct) vf[kt][ct] = *(const bf16x8*)(vp + (16 * ct) * 64 + voff);
    }
    __builtin_amdgcn_sched_barrier(0);
#pragma unroll
    for (int kt = 0; kt < 4; ++kt) if (kt < nkk) {
#pragma unroll
        for (int ct = 0; ct < 8; ++ct) acc[ct] = __builtin_amdgcn_mfma_f32_16x16x32_bf16(vf[kt][ct], wf[kt], acc[ct], 0, 0, 0);
    }
    __builtin_amdgcn_sched_barrier(0);
    float ss = 0.f;
#pragma unroll
    for (int ct = 0; ct < 8; ++ct) { float uu[4]; unpack4(uraw[ct], uu); f32x4 a = acc[ct];
#pragma unroll
        for (int i = 0; i < 4; ++i) { a[i] = uu[i] * (a[i] + bias); ss += a[i] * a[i]; }
        acc[ct] = a; }
    ss += shx(ss, 16, lane); ss += shx(ss, 32, lane);
    return ss;
}
__device__ __forceinline__ void sgu_chunk(int l, int cu, const bf16* PROJ, const bf16* VT, const bf16* SGUW, const float* sgu_b, bf16* YU, LAS unsigned char* vbuf, int wave, int lane) {
    const bool samp = cu >= 128;
    const int chunk0 = samp ? (MP + (cu - 128) * DSEQ) : cu * 128, nst = samp ? 4 : 8, npc = samp ? 2 : 4;
    const int tid = wave * 64 + lane, tr = lane & 15, kq = lane >> 4;
    const int s0 = 16 * wave; const bool active = wave < nst; const int row = chunk0 + s0 + tr;
    const int nk = (s0 + 47) >> 5;
    const bf16* vsrc = VT + (size_t)(chunk0 >> 6) * 768 * 64;
    v4u st[4];
#pragma unroll
    for (int i = 0; i < 4; ++i) if (i < npc) { const int q = tid + 512 * i; st[i] = *(const v4u*)(vsrc + (size_t)(q >> 10) * 768 * 64 + (q & 1023) * 8); } else st[i] = (v4u){0u, 0u, 0u, 0u};
#pragma unroll
    for (int i = 0; i < 4; ++i) if (i < npc) *(LAS v4u*)(vbuf + (tid + 512 * i) * 16) = st[i];
    LDS_WAIT(); __builtin_amdgcn_s_barrier(); asm volatile("" ::: "memory");
    u32x2 ypk[6][8]; float ss = 0.f;
#pragma unroll
    for (int h = 0; h < 6; ++h) {
        if (h + 1 < 6) {
#pragma unroll
            for (int i = 0; i < 4; ++i) if (i < npc) { const int q = tid + 512 * i; st[i] = *(const v4u*)(vsrc + (size_t)(h + 1) * 128 * 64 + (size_t)(q >> 10) * 768 * 64 + (q & 1023) * 8); }
        }
        const LAS unsigned char* vb = vbuf + (h & 1) * 32768 + tr * 128 + kq * 16;
        if (active) {
            u32x2 uraw[8];
#pragma unroll
            for (int ct = 0; ct < 8; ++ct) uraw[ct] = *(const u32x2*)(PROJ + (size_t)row * INW + C_U + h * 128 + 16 * ct + 4 * kq);
            const float bias = sgu_b[(size_t)(l * 6 + h) * 128 + s0 + tr];
            const bf16* Wrow = SGUW + ((size_t)(l * 6 + h) * 128 + s0) * 128 + tr * 128 + 8 * kq;
            bf16x8 wf[4];
#pragma unroll
            for (int kt = 0; kt < 4; ++kt) wf[kt] = (kt < nk) ? *(const bf16x8*)(Wrow + 32 * kt) : (bf16x8){0, 0, 0, 0, 0, 0, 0, 0};
            f32x4 acc[8];
#pragma unroll
            for (int ct = 0; ct < 8; ++ct) acc[ct] = (f32x4){0.f, 0.f, 0.f, 0.f};
#pragma unroll
            for (int kt = 0; kt < 4; ++kt) if (kt < nk) {
#pragma unroll
                for (int ct = 0; ct < 8; ++ct) { const bf16x8 vf = *(const LAS bf16x8*)(vb + (kt >> 1) * 16384 + (kt & 1) * 64 + ct * 2048);
                    acc[ct] = __builtin_amdgcn_mfma_f32_16x16x32_bf16(vf, wf[kt], acc[ct], 0, 0, 0); }
            }
#pragma unroll
            for (int ct = 0; ct < 8; ++ct) { float uu[4], y[4]; unpack4(uraw[ct], uu);
#pragma unroll
                for (int i = 0; i < 4; ++i) { y[i] = uu[i] * (acc[ct][i] + bias); ss += y[i] * y[i]; }
                ypk[h][ct].x = pg8::cvt_pk_bf16(y[0], y[1]); ypk[h][ct].y = pg8::cvt_pk_bf16(y[2], y[3]); }
        } else {
#pragma unroll
            for (int ct = 0; ct < 8; ++ct) ypk[h][ct] = (u32x2){0u, 0u};
        }
        if (h + 1 < 6) {
#pragma unroll
            for (int i = 0; i < 4; ++i) if (i < npc) *(LAS v4u*)(vbuf + ((h + 1) & 1) * 32768 + (tid + 512 * i) * 16) = st[i];
        }
        LDS_WAIT(); __builtin_amdgcn_s_barrier(); asm volatile("" ::: "memory");
    }
    if (active) {
        ss += shx(ss, 16, lane); ss += shx(ss, 32, lane);
        const float r = __builtin_amdgcn_rsqf(ss * (1.0f / 768.0f) + EPS);
#pragma unroll
        for (int h = 0; h < 6; ++h)
#pragma unroll
            for (int ct = 0; ct < 8; ++ct) { float y[4]; unpack4(ypk[h][ct], y); u32x2 o; o.x = pg8::cvt_pk_bf16(y[0] * r, y[1] * r); o.y = pg8::cvt_pk_bf16(y[2] * r, y[3] * r);
                *(u32x2*)(YU + (size_t)row * DM + 1280 + h * 128 + 16 * ct + 4 * kq) = o; }
    }
}

constexpr int I_BIG = (DM / 64) * (DFF / 128), I_IN = (DM / 64) * (INW / 128), I_OUT = (DM / 64) * (DM / 128), I_LAYER = 6 * I_BIG + I_IN + I_OUT;
static_assert(I_BIG == (DFF / 64) * (DM / 128) && DFF % 128 == 0 && INW % 128 == 0, "gate/up and down item counts match");
constexpr int GU_UNITS = (M / 256) * (2 * DFF / 256), TAIL_WG0 = GU_UNITS - (GU_UNITS / 256) * 256, TAIL_WAVES = (256 - TAIL_WG0) * NWAVES, TAIL_N = 2, TAIL_ITEMS = TAIL_WAVES * TAIL_N;
static_assert(TAIL_WG0 == 96 && 2 * TAIL_ITEMS <= I_LAYER, "tail conversion split");
__device__ __forceinline__ void cvt_layer_item(const float* const* in, unsigned char* ws, int l, int r, LAS unsigned char* scr, int lane) {
    const float* norm_gains = in[17];
    const float* W; const float* gain; bf16* WT; int K, N, sh = 7, add = 0;
    if (r < 4 * I_BIG) { const int j = r / I_BIG; r -= j * I_BIG; const int f = j >> 1, up = j & 1;
        W = in[11 + 3 * f + up] + (size_t)l * DM * DFF; gain = norm_gains + (size_t)(l * 6 + 4 * f) * DM; WT = (bf16*)(ws + WS_WGU) + (size_t)(2 * l + f) * (2 * DFF * DM); K = DM; N = DFF; sh = 8; add = 128 * up; }
    else if (r < 6 * I_BIG) { r -= 4 * I_BIG; const int f = r / I_BIG; r -= f * I_BIG;
        W = in[13 + 3 * f] + (size_t)l * DFF * DM; gain = nullptr; WT = (bf16*)(ws + WS_WD) + (size_t)(2 * l + f) * (DM * DFF); K = DFF; N = DM; }
    else if (r < 6 * I_BIG + I_IN) { r -= 6 * I_BIG; W = in[4] + (size_t)l * DM * INW; gain = norm_gains + (size_t)(l * 6 + 2) * DM; WT = (bf16*)(ws + WS_WIN) + (size_t)l * (INW * DM); K = DM; N = INW; }
    else { r -= 6 * I_BIG + I_IN; W = in[5] + (size_t)l * DM * DM; gain = in[18] + (size_t)l * DM; WT = (bf16*)(ws + WS_WOUT) + (size_t)l * (DM * DM); K = DM; N = DM; }
    cvt_item(W, K, N, gain, WT, sh, add, scr, r, lane);
}

struct Args { const float* in[19]; float* out; unsigned char* ws; int step_lo, step_hi, use_bar, pad; };
constexpr int N_STEPS = 1 + 8 * 8;
#ifndef GP_ALIGN
#define GP_ALIGN true
#endif
#ifndef GP_SP2
#define GP_SP2 true
#endif
#ifndef MIXP
#define MIXP 0
#endif
#ifndef PROBE_DUP
#define PROBE_DUP 0
#endif
#define REPS(bit) (((PROBE_DUP >> (bit)) & 1) ? 2 : 1)
#define PHASE_ENV \
    int z_ = 0; asm volatile("" : "+s"(z_)); \
    const int lane = (int)__builtin_amdgcn_mbcnt_hi(~0u, __builtin_amdgcn_mbcnt_lo(~0u, (unsigned)z_)); \
    const int wave = __builtin_amdgcn_readfirstlane(wave0 + z_); const int tid = wave * 64 + lane; \
    const int G = (int)gridDim.x, bx = (int)blockIdx.x + z_; \
    const int vcu = (G % 8 == 0) ? (bx % 8) * (G / 8) + bx / 8 : bx; \
    const int gw = vcu * NWAVES + wave, ngw = G * NWAVES; \
    unsigned char* ws = args.ws + z_; float* out = args.out + z_; float* X = out; \
    bf16* XB = (bf16*)(ws + WS_XB); bf16* HB = (bf16*)(ws + WS_H); bf16* PROJ = HB; bf16* D16 = (bf16*)(ws + WS_D); float* DSL = (float*)(ws + WS_DSL); bf16* YU = (bf16*)(ws + WS_YU); \
    float* SSX = (float*)(ws + WS_SSX); \
    (void)lane; (void)tid; (void)gw; (void)ngw; (void)X; (void)XB; (void)HB; (void)PROJ; (void)D16; (void)DSL; (void)YU; (void)SSX; (void)bx;

__global__ void __launch_bounds__(NWAVES * 64, 2) fwd(Args args) {
    extern __shared__ __attribute__((aligned(16))) unsigned char lds_raw[];
    LAS unsigned char* lds = (LAS unsigned char*)lds_raw;
    volatile LAS unsigned* MISC = (volatile LAS unsigned*)(lds + MISC_OFF);
    const int wave0 = __builtin_amdgcn_readfirstlane((int)threadIdx.x >> 6);
    for (int u = threadIdx.x; u < (LDS_BYTES - MISC_OFF) / 4; u += NWAVES * 64) MISC[u] = 0u;
    __syncthreads();
    XcdBarrier bar; bar.bar = (unsigned*)(args.ws + WS_CTL) + CW_BAR; bar.x = 0; bar.st = nullptr;
    if (args.use_bar) bar = xcd_barrier_post((unsigned*)(args.ws + WS_CTL) + CW_BAR, MISC + 8);
#define GRID_BAR() do { if (args.use_bar) xcd_barrier(bar, tid == 0); } while (0)
    const int lo = args.step_lo, hi = args.step_hi;
#define IN(k) (lo <= (k) && (k) < hi)

    if (IN(0)) for (int rep = 0; rep < REPS(0); ++rep) {
        PHASE_ENV
        bf16* POOLW = (bf16*)(ws + WS_POOLW); bf16* SGUW = (bf16*)(ws + WS_SGUW);
        LAS unsigned char* scr = lds + wave * 16384;
        constexpr int I_REST = I_LAYER - 2 * TAIL_ITEMS;
        for (int it = gw; it < I_LAYER + (NLAYER - 1) * I_REST; it += ngw) {
            int l = 0, r = it;
            if (it >= I_LAYER) { l = 1 + (it - I_LAYER) / I_REST; r = 2 * TAIL_ITEMS + (it - I_LAYER) % I_REST; }
            cvt_layer_item(args.in, ws, l, r, scr, lane);
        }
        const int gt = vcu * (NWAVES * 64) + tid, ngt = G * NWAVES * 64;
        const float* pool_w = args.in[6]; const float* pool_scale = args.in[7]; const float* sgu_w = args.in[9];
        for (int o = gt; o < NLAYER * 4 * 128 * 128; o += ngt) {
            const int c = o & 127, d = (o >> 7) & 127, lg = o >> 14; POOLW[o] = (bf16)f2bf(pool_w[((size_t)lg * 128 + c) * 128 + d] * pool_scale[(size_t)lg * 128 + d]); }
        for (int o = gt; o < NLAYER * 6 * 128 * 128; o += ngt) {
            const int t = o & 127, sr = (o >> 7) & 127; SGUW[o] = (t <= sr) ? (bf16)f2bf(sgu_w[o]) : (bf16)0; }
        const float* x_prompt = args.in[0]; const float* x_sample = args.in[1];
        for (int row = gw; row < M; row += ngw) {
            const f32x4* src = (const f32x4*)(row < MP ? x_prompt + (size_t)row * DM : x_sample + (size_t)(row - MP) * DM) + lane;
            u32x2* xb = (u32x2*)(XB + (size_t)row * DM) + lane; float ss = 0.f;
#pragma unroll
            for (int j = 0; j < 8; ++j) { const f32x4 x = src[64 * j]; u32x2 w; w.x = pg8::cvt_pk_bf16(x[0], x[1]); w.y = pg8::cvt_pk_bf16(x[2], x[3]); xb[64 * j] = w;
                ss += (x[0] * x[0] + x[1] * x[1]) + (x[2] * x[2] + x[3] * x[3]); }
            ss = wave_sum(ss, lane); if (lane == 0) SSX[row] = ss;
        }
        GRID_BAR();
    }

    for (int s = 0; s < 8; ++s) {
        const int l = s >> 1, f = s & 1, base = 1 + s * 8;
        if (IN(base + 0)) for (int rep = 0; rep < REPS(1); ++rep) {
            PHASE_ENV
            pg8::Gemm g{XB, (bf16*)(ws + WS_WGU) + (size_t)s * (2 * DFF * DM), M, 2 * DFF, DM}; pg8::StaticOrder S; S.init(M, 2 * DFF, DM, G, bx);
            EpiGateUp E{HB, SSX};
            pg8::gemm_phase<EpiGateUp, pg8::StaticOrder, GP_ALIGN, GP_SP2>(lds, g, S, E, tid);
            if (l + 1 < NLAYER && bx >= TAIL_WG0 && rep == 0) {
                const int widx = (bx - TAIL_WG0) * NWAVES + wave;
                for (int k = 0; k < TAIL_N; ++k) cvt_layer_item(args.in, ws, l + 1, f * TAIL_ITEMS + k * TAIL_WAVES + widx, lds + wave * 16384, lane);
            }
            GRID_BAR();
        }
        if (IN(base + 1)) for (int rep = 0; rep < REPS(2); ++rep) {
            PHASE_ENV
            pg8::Gemm g{HB, (bf16*)(ws + WS_WD) + (size_t)s * (DM * DFF), M, DM, DFF}; pg8::SplitOrder S; S.init(DFF, bx);
            EpiD E{D16, DSL};
            pg8::gemm_phase<EpiD, pg8::SplitOrder, GP_ALIGN, GP_SP2>(lds, g, S, E, tid);
            GRID_BAR();
        }
        if (IN(base + 2)) for (int rep = 0; rep < REPS(3); ++rep) { PHASE_ENV ew_phase(X, XB, SSX, D16, DSL, args.in[17] + (size_t)(l * 6 + (f ? 5 : 1)) * DM, (rep + 1 == REPS(3)) ? 0.5f : 0.0f, s == 7 && rep + 1 == REPS(3), gw, ngw, lane); if (s != 7) GRID_BAR(); }
        if (f == 0) {
            if (IN(base + 3)) for (int rep = 0; rep < REPS(4); ++rep) {
                PHASE_ENV
                pg8::Gemm g{XB, (bf16*)(ws + WS_WIN) + (size_t)l * (INW * DM), M, INW, DM};
                { pg8::StaticOrder S; S.init(M, C_V, DM, G, bx, 0); EpiProj E{PROJ, SSX};
                  pg8::gemm_phase<EpiProj, pg8::StaticOrder, GP_ALIGN, GP_SP2>(lds, g, S, E, tid); }
                { pg8::StaticOrder S; S.init(M, INW - C_V, DM, G, bx, C_V / 256); EpiVT E{(bf16*)(ws + WS_VT), SSX, out + O_VS + (size_t)l * MS * 768};
                  pg8::gemm_phase<EpiVT, pg8::StaticOrder, GP_ALIGN, GP_SP2, true>(lds, g, S, E, tid); }
                GRID_BAR();
            }
            if (IN(base + 4)) for (int rep = 0; rep < REPS(5); ++rep) {
                {
                PHASE_ENV
                const float* state_pool = args.in[2]; const float* state_conv = args.in[3]; const float* conv_w = args.in[8]; const float* sgu_b = args.in[10];
                const bf16* POOLW = (const bf16*)(ws + WS_POOLW); const bf16* SGUW = (const bf16*)(ws + WS_SGUW);
                const bf16* VT = (const bf16*)(ws + WS_VT);
                if (vcu < 160) sgu_chunk(l, vcu, PROJ, VT, SGUW, sgu_b, YU, lds, wave, lane);
                LAS float* tab = (LAS float*)(lds + 65536); int par = 0;
                const int npass = (vcu >= 192) ? 3 : 2;
                for (int k = 0; k < npass; ++k, par ^= 1) {
                    int zp = 0; asm volatile("" : "+s"(zp));
                    const int ln = (int)__builtin_amdgcn_mbcnt_hi(~0u, __builtin_amdgcn_mbcnt_lo(~0u, (unsigned)zp));
                    const int tr = ln & 15, kq = ln >> 4, g = wave & 3;
                    int pass;
                    if (vcu < 160) pass = k * 256 + vcu;
                    else if (vcu < 192) pass = (k == 0) ? (512 + 2 * (vcu - 160)) : vcu;
                    else pass = (k == 0) ? vcu : (k == 1) ? (416 + vcu - 192) : ((vcu < 224) ? (480 + vcu - 192) : (513 + 2 * (vcu - 224)));
                    const int tb = 2 * pass + (wave >> 2);
                    LAS float* T = tab + par * 512 + (wave >> 2) * 256 + tr * 16; const int row = tb * 16 + tr;
                    f32x4 a0[8];
                    const float s0 = pool_compute(l, tb, g, PROJ, state_pool, POOLW, a0, ln); if (kq == 0) T[g] = s0;
                    conv_quad(l, tb * 4 + g, PROJ, state_conv, conv_w, YU, ln);
                    LDS_WAIT(); __builtin_amdgcn_s_barrier(); asm volatile("" ::: "memory");
                    const float r = __builtin_amdgcn_rsqf(((T[0] + T[1]) + (T[2] + T[3])) * (1.0f / 512.0f) + EPS);
                    tile_store(a0, r, YU + (size_t)row * DM + g * 128 + 4 * kq);
                }
                }
                {
                PHASE_ENV
                const int gt = vcu * (NWAVES * 64) + tid, ngt = G * NWAVES * 64;
                for (int o = gt; o < (2 + DB) * 15 * 512; o += ngt) { const int c = o & 511, ri = o >> 9, b = ri / 15, i = ri - b * 15;
                    if (b < 2) out[O_PP + ((size_t)(l * 2 + b) * 15 + i) * 512 + c] = bf2f(PROJ[(size_t)(b * SEQ + SEQ - 15 + i) * INW + C_P + c]);
                    else out[O_PS + ((size_t)(l * DB + (b - 2)) * 15 + i) * 512 + c] = bf2f(PROJ[(size_t)(MP + (b - 2) * DSEQ + DSEQ - 15 + i) * INW + C_P + c]); }
                for (int o = gt; o < (2 + DB) * 2 * 768; o += ngt) { const int c = o % 768, ri = o / 768, b = ri >> 1, i = ri & 1;
                    const size_t row = b < 2 ? (size_t)(b * SEQ + SEQ - 2 + i) : (size_t)(MP + (b - 2) * DSEQ + DSEQ - 2 + i);
                    const float zz = bf2f(PROJ[row * INW + C_CG + c]) * bf2f(PROJ[row * INW + C_H + c]);
                    if (b < 2) out[O_CP + ((size_t)(l * 2 + b) * 2 + i) * 768 + c] = zz; else out[O_CS + ((size_t)(l * DB + (b - 2)) * 2 + i) * 768 + c] = zz; }
                GRID_BAR();
                }
            }
            if (IN(base + 6)) for (int rep = 0; rep < REPS(6); ++rep) {
                PHASE_ENV
                pg8::Gemm g{YU, (bf16*)(ws + WS_WOUT) + (size_t)l * (DM * DM), M, DM, DM}; pg8::SplitOrder S; S.init(DM, bx);
                EpiD E{D16, DSL};
                pg8::gemm_phase<EpiD, pg8::SplitOrder, GP_ALIGN, GP_SP2>(lds, g, S, E, tid);
                GRID_BAR();
            }
            if (IN(base + 7)) for (int rep = 0; rep < REPS(3); ++rep) { PHASE_ENV ew_phase(X, XB, SSX, D16, DSL, args.in[17] + (size_t)(l * 6 + 3) * DM, (rep + 1 == REPS(3)) ? 1.0f : 0.0f, false, gw, ngw, lane); GRID_BAR(); }
        }
    }
#undef IN
#undef GRID_BAR
}

#ifndef MK_ONE_LAUNCH
#define MK_ONE_LAUNCH 1
#endif
extern "C" void kernel_launch(void* const* d_in, const int* in_sizes, int n_in, void* d_out, int out_size, void* d_ws, size_t ws_size, hipStream_t stream) {
    static int grid = 0;
    if (grid == 0) {
        if (n_in != 19 || out_size != (int)O_END || ws_size < WS_END) { fprintf(stderr, "kernel_launch: unexpected shapes: n_in %d out %d ws %zu (need %zu); nothing launched\n", n_in, out_size, ws_size, (size_t)WS_END); grid = -1; return; }
        int dev = 0, cus = 0, per_cu = 0;
        if (hipGetDevice(&dev) != hipSuccess || hipDeviceGetAttribute(&cus, hipDeviceAttributeMultiprocessorCount, dev) != hipSuccess) { fprintf(stderr, "kernel_launch: device query failed\n"); grid = -1; return; }
        if (hipFuncSetAttribute((const void*)fwd, hipFuncAttributeMaxDynamicSharedMemorySize, LDS_BYTES) != hipSuccess) { fprintf(stderr, "kernel_launch: hipFuncSetAttribute failed\n"); grid = -1; return; }
        if (hipOccupancyMaxActiveBlocksPerMultiprocessor(&per_cu, (const void*)fwd, NWAVES * 64, LDS_BYTES) != hipSuccess || per_cu < 1) { fprintf(stderr, "kernel_launch: occupancy query reports %d workgroups per CU\n", per_cu); }
        (void)hipGetLastError();
        if (cus != 256) { fprintf(stderr, "kernel_launch: built for a 256-CU device (the split-K unit deal), found %d CUs; nothing launched\n", cus); grid = -1; return; }
        grid = cus;
    }
    if (grid < 0) return;
    if (hipMemsetAsync((char*)d_ws + WS_CTL, 0, CTL_ZERO_BYTES, stream) != hipSuccess) { fprintf(stderr, "kernel_launch: memset failed\n"); return; }
    Args a{};
    for (int i = 0; i < 19; ++i) a.in[i] = (const float*)d_in[i];
    a.out = (float*)d_out; a.ws = (unsigned char*)d_ws;
#if MK_ONE_LAUNCH
    a.step_lo = 0; a.step_hi = N_STEPS; a.use_bar = 1;
    hipLaunchKernelGGL(fwd, dim3(grid), dim3(NWAVES * 64), LDS_BYTES, stream, a);
#else
    for (int st = 0; st < N_STEPS; ++st) {
        if (st > 0) { const int s = (st - 1) >> 3, p = (st - 1) & 7; if (((s & 1) && p >= 3) || p == 5) continue; }
        a.step_lo = st; a.step_hi = st + 1; a.use_bar = 0;
        hipLaunchKernelGGL(fwd, dim3(grid), dim3(NWAVES * 64), LDS_BYTES, stream, a);
    }
#endif
    const hipError_t le = hipPeekAtLastError();
    if (le != hipSuccess) fprintf(stderr, "kernel_launch: launch failed: %s\n", hipGetErrorName(le));
}
```

```cpp
#include <hip/hip_runtime.h>
#include <cstdio>
#include <cstdint>
namespace pg8 {
#define PG8_LAS __attribute__((address_space(3)))
typedef unsigned short bf16_t;
typedef short bf16x8 __attribute__((ext_vector_type(8)));
typedef float f32x4 __attribute__((ext_vector_type(4)));
typedef unsigned u32x4 __attribute__((ext_vector_type(4)));
constexpr int BM = 256, BK = 64, HALF = 128, HTB = HALF * BK * 2  , STAGE_BYTES = 8 * HTB, NXCD = 8, WGM = 8;

__host__ __device__ __forceinline__ int lds_byte(int r, int c) { const int st = (r >> 4) * 2 + (c >> 5), rr = r & 15, cc = c & 31, ob = rr * 64 + cc * 2; return st * 1024 + (ob ^ (((ob >> 9) & 1) << 5)); }
__host__ __device__ __forceinline__ void stage_rc(int b, int& R, int& C) { const int st = b / 1024, sb = b % 1024, swz = sb ^ (((sb >> 9) & 1) << 5); R = (st >> 1) * 16 + swz / 64; C = (st & 1) * 32 + (swz % 64) / 2; }
__host__ __device__ __forceinline__ int perm32(int rho) { const int n = rho >> 4, i = rho & 15; return 8 * (i >> 2) + 4 * n + (i & 3); }

struct Unit { int pm, pn, kb, nt, slab; };
struct Gemm { const bf16_t* A; const bf16_t* Bt; int M, N, K; };

struct StaticOrder {
    int nM, nN, nwg, G, c, ntK, pn0;
    __host__ __device__ void init(int M, int N, int K, int G_, int c_, int pn0_ = 0) { nM = M / BM; nN = N / BM; nwg = nM * nN; G = G_; c = c_; ntK = K / BK; pn0 = pn0_; }
    __host__ __device__ bool next(int i, Unit& u) const {
        const long L = (long)i * G + c; if (L >= nwg) return false;
        int wgid = (int)L; { const int q = nwg / NXCD, r = nwg % NXCD, xcd = wgid % NXCD, off = wgid / NXCD; wgid = (xcd < r ? xcd * (q + 1) : r * (q + 1) + (xcd - r) * q) + off; }
        const int nig = WGM * nN, gid = wgid / nig, fm = gid * WGM, gsz = (nM - fm) < WGM ? (nM - fm) : WGM;
        u.pm = fm + ((wgid % nig) % gsz); u.pn = pn0 + (wgid % nig) / gsz; u.kb = 0; u.nt = ntK; u.slab = 0; return true;
    }
    __device__ __forceinline__ void a_ready(const Unit&) const {}
    __device__ __forceinline__ void done(const Unit&) const {}
};
struct SplitOrder {
    int c, ntK;
    __host__ __device__ void init(int K, int c_) { c = c_; ntK = K / BK; }
    __host__ __device__ bool next(int i, Unit& u) const {
        if (i < 2) { const int L = i * 256 + c, wgid = (L & 7) * 64 + (L >> 3), w64 = wgid & 63;
            u.pm = (wgid >> 6) * 8 + (w64 & 7); u.pn = w64 >> 3; u.kb = 0; u.nt = ntK; u.slab = 0; return true; }
        if (i == 2) { const int j = c >> 3, q = j >> 3; u.pm = 64 + (c & 7); u.pn = j & 7; u.nt = ntK >> 2; u.kb = q * u.nt; u.slab = 1 + q; return true; }
        return false;
    }
    __device__ __forceinline__ void a_ready(const Unit&) const {}
    __device__ __forceinline__ void done(const Unit&) const {}
};

__device__ __forceinline__ unsigned cvt_pk_bf16(float lo, float hi) { unsigned r; asm volatile("v_cvt_pk_bf16_f32 %0, %1, %2" : "=v"(r) : "v"(lo), "v"(hi)); return r; }
template <class Epi, class Sched, bool ALIGN_EPI = false, bool SP2 = false, bool SWAP = false>
__device__ __forceinline__ void gemm_phase(PG8_LAS unsigned char* lds, const Gemm g, const Sched& S, const Epi& E, const int tid) {
    const int wid = __builtin_amdgcn_readfirstlane(tid >> 6), lane = tid & 63, wr = wid >> 2, wc = wid & 3, fr = lane & 15, fq = lane >> 4;
    const int K = g.K;
    unsigned voffA[2], voffB[2];
#pragma unroll
    for (int i = 0; i < 2; ++i) { int R, C; stage_rc(tid * 16 + i * 8192, R, C); const int Rb = Epi::PERM ? ((R & ~31) + perm32(R & 31)) : R;
        voffA[i] = (unsigned)(R * K + C) * 2u; voffB[i] = (unsigned)(Rb * K + C) * 2u; }
    const size_t kstep = (size_t)(BK * 2);
    const size_t hstep = (size_t)HALF * K * 2;
    const size_t tstep = 2 * hstep;
    const unsigned ldsw = (unsigned)wid * 1024u;
    const int aoff = lds_byte(wr * 64 + fr, fq * 8), boff = lds_byte(wc * 32 + fr, fq * 8);
#define PG8_SA(b, h) (((b) * 2 + (h)) * HTB)
#define PG8_SB(b, h) ((4 + (b) * 2 + (h)) * HTB)
#define PG8_STAGE(bufoff, gbase, voff) do { _Pragma("unroll") for (int _i = 0; _i < 2; ++_i) \
        __builtin_amdgcn_global_load_lds((const unsigned*)((const char*)(gbase) + (voff)[_i]), (PG8_LAS unsigned*)(lds + (bufoff) + ldsw + _i * 8192), 16, 0, 0); } while (0)
#define PG8_LDA(dst, b, h) do { _Pragma("unroll") for (int m = 0; m < 4; ++m) _Pragma("unroll") for (int k = 0; k < 2; ++k) dst[m][k] = *(const PG8_LAS bf16x8*)(lds + PG8_SA(b, h) + aoff + m * 2048 + k * 1024); } while (0)
#define PG8_LDB(dst, b, h) do { _Pragma("unroll") for (int n = 0; n < 2; ++n) _Pragma("unroll") for (int k = 0; k < 2; ++k) dst[n][k] = *(const PG8_LAS bf16x8*)(lds + PG8_SB(b, h) + boff + n * 2048 + k * 1024); } while (0)
#define PG8_MMA(ai, bj, At, Bt) do { __builtin_amdgcn_s_setprio(1); _Pragma("unroll") for (int m = 0; m < 4; ++m) _Pragma("unroll") for (int n = 0; n < 2; ++n) _Pragma("unroll") for (int k = 0; k < 2; ++k) \
        acc[ai][bj][m][n] = SWAP ? __builtin_amdgcn_mfma_f32_16x16x32_bf16(At[m][k], Bt[n][k], acc[ai][bj][m][n], 0, 0, 0) : __builtin_amdgcn_mfma_f32_16x16x32_bf16(Bt[n][k], At[m][k], acc[ai][bj][m][n], 0, 0, 0); __builtin_amdgcn_s_setprio(0); } while (0)
#define PG8_MMA2(ai, bj, At, Bt, ai2, bj2, At2, Bt2) do { __builtin_amdgcn_s_setprio(1); _Pragma("unroll") for (int m = 0; m < 4; ++m) _Pragma("unroll") for (int n = 0; n < 2; ++n) _Pragma("unroll") for (int k = 0; k < 2; ++k) \
        acc[ai][bj][m][n] = SWAP ? __builtin_amdgcn_mfma_f32_16x16x32_bf16(At[m][k], Bt[n][k], acc[ai][bj][m][n], 0, 0, 0) : __builtin_amdgcn_mfma_f32_16x16x32_bf16(Bt[n][k], At[m][k], acc[ai][bj][m][n], 0, 0, 0); \
        _Pragma("unroll") for (int m = 0; m < 4; ++m) _Pragma("unroll") for (int n = 0; n < 2; ++n) _Pragma("unroll") for (int k = 0; k < 2; ++k) \
        acc[ai2][bj2][m][n] = SWAP ? __builtin_amdgcn_mfma_f32_16x16x32_bf16(At2[m][k], Bt2[n][k], acc[ai2][bj2][m][n], 0, 0, 0) : __builtin_amdgcn_mfma_f32_16x16x32_bf16(Bt2[n][k], At2[m][k], acc[ai2][bj2][m][n], 0, 0, 0); __builtin_amdgcn_s_setprio(0); } while (0)
#define PG8_WAIT_V(n) asm volatile("s_waitcnt vmcnt(" #n ")" ::: "memory")
#define PG8_WAIT_L(n) asm volatile("s_waitcnt lgkmcnt(" #n ")" ::: "memory")
#define PG8_BAR __builtin_amdgcn_s_barrier()
#define PG8_SCHED __builtin_amdgcn_sched_barrier(0)
    Unit cur, nxt; int ui = 0;
    if (!S.next(0, cur)) return;
    f32x4 acc[2][2][4][2];
#pragma unroll
    for (int a = 0; a < 2; ++a)
#pragma unroll
        for (int b = 0; b < 2; ++b)
#pragma unroll
            for (int m = 0; m < 4; ++m)
#pragma unroll
                for (int n = 0; n < 2; ++n) acc[a][b][m][n] = (f32x4){0.f, 0.f, 0.f, 0.f};
    bf16x8 At[4][2], B0[2][2], B1[2][2];
    const char* cA = (const char*)g.A + (size_t)cur.pm * tstep + (size_t)cur.kb * kstep; const char* cB = (const char*)g.Bt + (size_t)cur.pn * tstep + (size_t)cur.kb * kstep;
    S.a_ready(cur);
    if constexpr (SP2) {
        PG8_STAGE(PG8_SB(0, 0), cB, voffB); PG8_STAGE(PG8_SB(0, 1), cB + hstep, voffB); PG8_STAGE(PG8_SA(0, 0), cA, voffA); PG8_STAGE(PG8_SA(0, 1), cA + hstep, voffA);
        if (wr == 1) PG8_BAR;
        PG8_WAIT_V(2); PG8_BAR;
        PG8_STAGE(PG8_SB(1, 0), cB + kstep, voffB); PG8_STAGE(PG8_SA(1, 0), cA + kstep, voffA); PG8_STAGE(PG8_SB(1, 1), cB + hstep + kstep, voffB);
        PG8_WAIT_V(6); PG8_BAR;
    } else {
        PG8_STAGE(PG8_SB(0, 0), cB, voffB); PG8_STAGE(PG8_SA(0, 0), cA, voffA); PG8_STAGE(PG8_SB(0, 1), cB + hstep, voffB); PG8_STAGE(PG8_SA(0, 1), cA + hstep, voffA);
        if (wr == 1) PG8_BAR;
        PG8_WAIT_V(4); PG8_BAR;
        PG8_STAGE(PG8_SB(1, 0), cB + kstep, voffB); PG8_STAGE(PG8_SA(1, 0), cA + kstep, voffA); PG8_STAGE(PG8_SB(1, 1), cB + hstep + kstep, voffB);
        PG8_WAIT_V(6); PG8_BAR;
    }
    for (;;) {
        const bool has_next = S.next(ui + 1, nxt);
        const char* nA = has_next ? (const char*)g.A + (size_t)nxt.pm * tstep + (size_t)nxt.kb * kstep : cA; const char* nB = has_next ? (const char*)g.Bt + (size_t)nxt.pn * tstep + (size_t)nxt.kb * kstep : cB;
        const int nt = cur.nt;
        for (int t = 0; t < nt; t += 2) {
            const bool last = (t == nt - 2);
            const char* a1 = cA + (size_t)(t + 1) * kstep;
            const char* a2 = last ? nA : cA + (size_t)(t + 2) * kstep; const char* b2 = last ? nB : cB + (size_t)(t + 2) * kstep;
            const char* a3 = a2 + kstep; const char* b3 = b2 + kstep;
            if (last && has_next) S.a_ready(nxt);
            if constexpr (SP2) {
            PG8_LDB(B0, 0, 0); PG8_LDB(B1, 0, 1); PG8_SCHED; PG8_LDA(At, 0, 0); PG8_STAGE(PG8_SA(1, 1), a1 + hstep, voffA);
            PG8_WAIT_V(8); PG8_WAIT_L(0); PG8_BAR; PG8_MMA2(0, 0, At, B0, 0, 1, At, B1); PG8_BAR; PG8_SCHED;
            PG8_LDA(At, 0, 1); PG8_STAGE(PG8_SB(0, 0), b2, voffB); PG8_STAGE(PG8_SB(0, 1), b2 + hstep, voffB); PG8_STAGE(PG8_SA(0, 0), a2, voffA);
            PG8_WAIT_V(8); PG8_WAIT_L(0); PG8_BAR; PG8_MMA2(1, 0, At, B0, 1, 1, At, B1); PG8_BAR; PG8_SCHED;
            PG8_LDB(B0, 1, 0); PG8_LDB(B1, 1, 1); PG8_SCHED; PG8_LDA(At, 1, 0); PG8_STAGE(PG8_SA(0, 1), a2 + hstep, voffA);
            PG8_WAIT_V(8); PG8_WAIT_L(0); PG8_BAR; PG8_MMA2(0, 0, At, B0, 0, 1, At, B1); PG8_BAR; PG8_SCHED;
            PG8_LDA(At, 1, 1); PG8_STAGE(PG8_SB(1, 0), b3, voffB); PG8_STAGE(PG8_SB(1, 1), b3 + hstep, voffB); PG8_STAGE(PG8_SA(1, 0), a3, voffA);
            PG8_WAIT_V(8); PG8_WAIT_L(0); PG8_BAR; PG8_MMA2(1, 0, At, B0, 1, 1, At, B1); PG8_BAR; PG8_SCHED;
            } else {
            PG8_LDB(B0, 0, 0); PG8_SCHED; PG8_LDA(At, 0, 0); PG8_STAGE(PG8_SA(1, 1), a1 + hstep, voffA);
            PG8_WAIT_L(8); PG8_BAR; PG8_WAIT_L(0); PG8_MMA(0, 0, At, B0); PG8_BAR; PG8_SCHED;
            PG8_LDB(B1, 0, 1); PG8_STAGE(PG8_SB(0, 0), b2, voffB);
            PG8_BAR; PG8_WAIT_L(0); PG8_MMA(0, 1, At, B1); PG8_BAR;
            PG8_LDA(At, 0, 1); PG8_STAGE(PG8_SA(0, 0), a2, voffA);
            PG8_BAR; PG8_WAIT_L(0); PG8_MMA(1, 0, At, B0); PG8_BAR; PG8_SCHED;
            PG8_STAGE(PG8_SB(0, 1), b2 + hstep, voffB);
            PG8_WAIT_V(6); PG8_BAR; PG8_MMA(1, 1, At, B1); PG8_BAR;
            PG8_LDB(B0, 1, 0); PG8_SCHED; PG8_LDA(At, 1, 0); PG8_STAGE(PG8_SA(0, 1), a2 + hstep, voffA);
            PG8_WAIT_L(8); PG8_BAR; PG8_WAIT_L(0); PG8_MMA(0, 0, At, B0); PG8_BAR; PG8_SCHED;
            PG8_LDB(B1, 1, 1); PG8_STAGE(PG8_SB(1, 0), b3, voffB);
            PG8_BAR; PG8_WAIT_L(0); PG8_MMA(0, 1, At, B1); PG8_BAR;
            PG8_LDA(At, 1, 1); PG8_STAGE(PG8_SA(1, 0), a3, voffA);
            PG8_BAR; PG8_WAIT_L(0); PG8_MMA(1, 0, At, B0); PG8_BAR; PG8_SCHED;
            PG8_STAGE(PG8_SB(1, 1), b3 + hstep, voffB);
            PG8_WAIT_V(6); PG8_BAR; PG8_MMA(1, 1, At, B1); PG8_BAR;
            }
        }
        if constexpr (ALIGN_EPI) { if (wr == 0) PG8_BAR; }
        if constexpr (!Epi::AFTER_DRAIN) { E(acc, cur, wr, wc, fr, fq); S.done(cur); }
        if (!has_next) break;
#pragma unroll
        for (int a = 0; a < 2; ++a)
#pragma unroll
            for (int b = 0; b < 2; ++b)
#pragma unroll
                for (int m = 0; m < 4; ++m)
#pragma unroll
                    for (int n = 0; n < 2; ++n) acc[a][b][m][n] = (f32x4){0.f, 0.f, 0.f, 0.f};
        cur = nxt; cA = nA; cB = nB; ++ui;
        if constexpr (ALIGN_EPI) { if (wr == 1) PG8_BAR; }
    }
    PG8_WAIT_V(0);
    if constexpr (!ALIGN_EPI) { if (wr == 0) PG8_BAR; }
    PG8_BAR;
    if constexpr (Epi::AFTER_DRAIN) { E.fused(acc, cur, wr, wc, fr, fq, lds, wid, lane); S.done(cur); }
#undef PG8_SA
#undef PG8_SB
#undef PG8_STAGE
#undef PG8_LDA
#undef PG8_LDB
#undef PG8_MMA
#undef PG8_MMA2
#undef PG8_WAIT_V
#undef PG8_WAIT_L
#undef PG8_BAR
#undef PG8_SCHED
}
}
#define GAS __attribute__((address_space(1)))
#define LAS __attribute__((address_space(3)))
typedef unsigned short bf16;
typedef unsigned v4u __attribute__((ext_vector_type(4)));
typedef float f32x4 __attribute__((ext_vector_type(4)));
typedef short bf16x8 __attribute__((ext_vector_type(8)));
typedef GAS unsigned gu32;
typedef GAS unsigned long long gu64;
#define RLX_AGENT __ATOMIC_RELAXED, __HIP_MEMORY_SCOPE_AGENT
#define LDS_WAIT() asm volatile("s_waitcnt lgkmcnt(0)" ::: "memory")
#define VM_WAIT() asm volatile("s_waitcnt vmcnt(0)" ::: "memory")
__device__ __forceinline__ unsigned long long rt() { return __builtin_amdgcn_s_memrealtime(); }
__device__ __forceinline__ unsigned f2bf(float f) { unsigned u = __builtin_bit_cast(unsigned, f); return (u + 0x7fffu + ((u >> 16) & 1u)) >> 16; }
__device__ __forceinline__ unsigned pk2(float lo, float hi) { return f2bf(lo) | (f2bf(hi) << 16); }

#define XB_TMO      128
#define XB_XCNT(j)  (256  + 64 * (j))
#define XB_XSUB(j)  (1280 + 64 * (j))
#define XB_XGEN(j)  (2304 + 64 * (j))
#define XB_TOP      3328
#define XB_TOPGEN   3392
#define XCD_BAR_WORDS 3456
#define XB_SPIN_CAP (1u << 18)

__device__ __forceinline__ unsigned xb_ld(unsigned* p)              { return __hip_atomic_load(p, __ATOMIC_RELAXED, __HIP_MEMORY_SCOPE_AGENT); }
__device__ __forceinline__ unsigned xb_add(unsigned* p, unsigned v) { return __hip_atomic_fetch_add(p, v, __ATOMIC_RELAXED, __HIP_MEMORY_SCOPE_AGENT); }
__device__ __forceinline__ unsigned xb_xcc_id() { return (unsigned)__builtin_amdgcn_s_getreg((3 << 11) | 20) & 0xFu; }
#define XB_SPIN(cond, bar) do { unsigned _sp = 0; while (cond) { __builtin_amdgcn_s_sleep(1); \
    if ((++_sp & 255u) == 0u) { if (xb_ld(&(bar)[XB_TMO])) break; if (_sp > XB_SPIN_CAP) { atomicAdd(&(bar)[XB_TMO], 1u); break; } } } } while (0)

struct XcdBarrier {
    unsigned* bar; unsigned x;
    volatile LAS unsigned* st;
};

__device__ __forceinline__ XcdBarrier xcd_barrier_post(unsigned* bar, volatile LAS unsigned* st) {
    XcdBarrier b; b.bar = bar; b.x = xb_xcc_id(); b.st = st;
    if (threadIdx.x == 0) (void)xb_add(&bar[XB_XCNT(b.x)], 1u);
    return b;
}
__device__ __forceinline__ void xcd_barrier_complete(unsigned* bar, unsigned x, unsigned& nloc, unsigned& nx) {
    const unsigned G = gridDim.x * gridDim.y * gridDim.z;
    unsigned sum, cnt, mine, sp = 0u;
    for (;;) {
        sum = 0u; cnt = 0u; mine = 0u;
#pragma unroll
        for (unsigned j = 0; j < 16; ++j) { const unsigned c = xb_ld(&bar[XB_XCNT(j)]); sum += c; cnt += (c > 0u) ? 1u : 0u; mine = (j == x) ? c : mine; }
        if (sum == G) break;
        __builtin_amdgcn_s_sleep(1);
        if ((++sp & 255u) == 0u) { if (xb_ld(&bar[XB_TMO])) break; if (sp > XB_SPIN_CAP) { atomicAdd(&bar[XB_TMO], 1u); break; } }
    }
    nloc = mine > 0u ? mine : 1u; nx = cnt > 0u ? cnt : 1u;
}

__device__ __forceinline__ void xcd_barrier(const XcdBarrier& b, const bool t0  ) {
    asm volatile("s_waitcnt vmcnt(0)" ::: "memory");
    __syncthreads();
    if (t0) {
        unsigned* bar = b.bar;
        __builtin_amdgcn_s_waitcnt(0);
        unsigned nloc = b.st[0], nx = b.st[1];
        if (nloc == 0u) { xcd_barrier_complete(bar, b.x, nloc, nx); b.st[0] = nloc; b.st[1] = nx; }
        const unsigned old = xb_add(&bar[XB_XSUB(b.x)], 1u);
        const unsigned gen = old / nloc;
        if (old + 1u == (gen + 1u) * nloc) {
            __builtin_amdgcn_fence(__ATOMIC_RELEASE, "agent");
            asm volatile("s_waitcnt vmcnt(0)" ::: "memory");
            const unsigned og = xb_add(&bar[XB_TOP], 1u);
            const unsigned tg = og / nx;
            if (og + 1u == (tg + 1u) * nx) xb_add(&bar[XB_TOPGEN], 1u);
            else XB_SPIN(xb_ld(&bar[XB_TOPGEN]) == tg, bar);
            __builtin_amdgcn_fence(__ATOMIC_ACQUIRE, "agent");
            xb_add(&bar[XB_XGEN(b.x)], 1u);
            asm volatile("s_waitcnt vmcnt(0)" ::: "memory");
        } else {
            XB_SPIN(xb_ld(&bar[XB_XGEN(b.x)]) == gen, bar);
            __builtin_amdgcn_fence(__ATOMIC_ACQUIRE, "agent");
            asm volatile("s_waitcnt vmcnt(0)" ::: "memory");
        }
    }
    __syncthreads();
}

constexpr int DM = 2048, DFF = 5632, INW = 4352, NLAYER = 4;
constexpr int SEQ = 8192, MP = 2 * SEQ, DSEQ = 64, DB = 32, MS = DB * DSEQ, M = MP + MS;
constexpr int C_P = 0, C_H = 512, C_BG = 1280, C_CG = 2048, C_U = 2816, C_V = 3584;
constexpr float EPS = 1e-6f;
constexpr int NWAVES = 8;
constexpr size_t O_YP = 0, O_YS = (size_t)MP * DM, O_PP = (size_t)M * DM, O_CP = O_PP + (size_t)NLAYER * 2 * 15 * 512, O_PS = O_CP + (size_t)NLAYER * 2 * 2 * 768,
                 O_CS = O_PS + (size_t)NLAYER * DB * 15 * 512, O_VS = O_CS + (size_t)NLAYER * DB * 2 * 768, O_END = O_VS + (size_t)NLAYER * DB * DSEQ * 768;
static_assert(O_END == 45293568, "d_out map");
constexpr size_t WS_CTL = 0, CTL_ZERO_BYTES = 1u << 20;
constexpr size_t SZ_WGU = (size_t)2 * DFF * DM * 2, SZ_WD = (size_t)DM * DFF * 2, SZ_WIN = (size_t)INW * DM * 2, SZ_WOUT = (size_t)DM * DM * 2, SZ_POOLW = (size_t)4 * 128 * 128 * 2, SZ_SGUW = (size_t)6 * 128 * 128 * 2;
constexpr size_t WS_WGU = 1u << 20, WS_WD = WS_WGU + 8 * SZ_WGU, WS_WIN = WS_WD + 8 * SZ_WD, WS_WOUT = WS_WIN + 4 * SZ_WIN, WS_POOLW = WS_WOUT + 4 * SZ_WOUT, WS_SGUW = WS_POOLW + 4 * SZ_POOLW;
constexpr size_t WS_XB = WS_SGUW + 4 * SZ_SGUW, WS_H = WS_XB + (size_t)M * DM * 2, WS_D = WS_H + (size_t)M * DFF * 2, WS_DSL = WS_D + (size_t)MP * DM * 2, WS_YU = WS_DSL + (size_t)4 * MS * DM * 4;
constexpr size_t WS_SSX = WS_YU + (size_t)M * DM * 2, WS_GS = WS_SSX + (size_t)M * 4, WS_VT = WS_GS + (size_t)M * 16 * 4, WS_END = WS_VT + (size_t)M * 768 * 2;
static_assert(WS_END <= 1475633152ull, "d_ws map exceeds the guaranteed workspace");
static_assert(WS_XB % 256 == 0 && WS_H % 256 == 0 && WS_D % 256 == 0 && WS_YU % 256 == 0 && WS_SSX % 256 == 0 && WS_DSL % 256 == 0 && WS_GS % 256 == 0, "alignment");
constexpr int CW_BAR = 4096;
constexpr int RING_BYTES = 131072, MISC_OFF = RING_BYTES, LDS_BYTES = RING_BYTES + 1024;

typedef unsigned u32x2 __attribute__((ext_vector_type(2)));
__device__ __forceinline__ float bf2f(unsigned short b) { return __builtin_bit_cast(float, (unsigned)b << 16); }
__device__ __forceinline__ float shx(float v, int o, int lane) { return __builtin_bit_cast(float, __builtin_amdgcn_ds_bpermute((lane ^ o) << 2, __builtin_bit_cast(int, v))); }
__device__ __forceinline__ float wave_sum(float v, int lane) {
#pragma unroll
    for (int o = 1; o < 64; o <<= 1) v += shx(v, o, lane);
    return v;
}
__device__ __forceinline__ void unpack8(bf16x8 v, float (&f)[8]) {
#pragma unroll
    for (int i = 0; i < 8; ++i) f[i] = bf2f((unsigned short)v[i]);
}
__device__ __forceinline__ void unpack4(u32x2 v, float (&f)[4]) {
    f[0] = __builtin_bit_cast(float, v.x << 16); f[1] = __builtin_bit_cast(float, v.x & 0xffff0000u);
    f[2] = __builtin_bit_cast(float, v.y << 16); f[3] = __builtin_bit_cast(float, v.y & 0xffff0000u);
}

struct EpiGateUp {
    static constexpr bool PERM = true, AFTER_DRAIN = false;
    bf16* H; const float* ssx;
    __device__ __forceinline__ void operator()(const pg8::f32x4 (&acc)[2][2][4][2], const pg8::Unit& u, int wr, int wc, int fr, int fq) const {
        const int row0 = u.pm * 256 + wr * 64 + fr, col0 = u.pn * 128 + wc * 32 + 8 * fq;
        float rs[2][4];
#pragma unroll
        for (int ai = 0; ai < 2; ++ai)
#pragma unroll
            for (int m = 0; m < 4; ++m) rs[ai][m] = ssx[row0 + ai * 128 + m * 16];
#pragma unroll
        for (int ai = 0; ai < 2; ++ai)
#pragma unroll
            for (int mp = 0; mp < 2; ++mp) {
                typedef float f32x2 __attribute__((ext_vector_type(2)));
                f32x2 gv[8], pv[8], tv[8];
#pragma unroll
                for (int mm = 0; mm < 2; ++mm) { const int m = 2 * mp + mm; const float r = __builtin_amdgcn_rsqf(rs[ai][m] * (1.0f / DM) + EPS), rc = r * -1.44269504f, r2 = r * r;
#pragma unroll
                    for (int n = 0; n < 2; ++n)
#pragma unroll
                        for (int e2 = 0; e2 < 2; ++e2) { const f32x2 g = (f32x2){acc[ai][0][m][n][2 * e2], acc[ai][0][m][n][2 * e2 + 1]}, uu = (f32x2){acc[ai][1][m][n][2 * e2], acc[ai][1][m][n][2 * e2 + 1]};
                            tv[4 * mm + 2 * n + e2] = g * rc;
                            pv[4 * mm + 2 * n + e2] = (g * uu) * r2; } }
#pragma unroll
                for (int i = 0; i < 8; ++i) { tv[i].x = __builtin_amdgcn_exp2f(tv[i].x); tv[i].y = __builtin_amdgcn_exp2f(tv[i].y); }
#pragma unroll
                for (int i = 0; i < 8; ++i) tv[i] = tv[i] + 1.0f;
#pragma unroll
                for (int i = 0; i < 8; ++i) { tv[i].x = __builtin_amdgcn_rcpf(tv[i].x); tv[i].y = __builtin_amdgcn_rcpf(tv[i].y); }
#pragma unroll
                for (int i = 0; i < 8; ++i) gv[i] = pv[i] * tv[i];
#pragma unroll
                for (int mm = 0; mm < 2; ++mm) { const int row = row0 + ai * 128 + (2 * mp + mm) * 16; const f32x2* hv = gv + 4 * mm;
                    v4u w; w.x = pg8::cvt_pk_bf16(hv[0].x, hv[0].y); w.y = pg8::cvt_pk_bf16(hv[1].x, hv[1].y); w.z = pg8::cvt_pk_bf16(hv[2].x, hv[2].y); w.w = pg8::cvt_pk_bf16(hv[3].x, hv[3].y);
                    *(v4u*)(H + (size_t)row * DFF + col0) = w; }
            }
    }
};
struct EpiProj {
    static constexpr bool PERM = true, AFTER_DRAIN = false;
    bf16* P; const float* ssx;
    __device__ __forceinline__ void operator()(const pg8::f32x4 (&acc)[2][2][4][2], const pg8::Unit& u, int wr, int wc, int fr, int fq) const {
        const int row0 = u.pm * 256 + wr * 64 + fr, col0 = u.pn * 256 + wc * 32 + 8 * fq;
        float rs[2][4];
#pragma unroll
        for (int ai = 0; ai < 2; ++ai)
#pragma unroll
            for (int m = 0; m < 4; ++m) rs[ai][m] = ssx[row0 + ai * 128 + m * 16];
#pragma unroll
        for (int ai = 0; ai < 2; ++ai)
#pragma unroll
            for (int m = 0; m < 4; ++m) {
                const int row = row0 + ai * 128 + m * 16;
                const float r = __builtin_amdgcn_rsqf(rs[ai][m] * (1.0f / DM) + EPS);
#pragma unroll
                for (int bj = 0; bj < 2; ++bj) { const pg8::f32x4 v0 = acc[ai][bj][m][0] * r, v1 = acc[ai][bj][m][1] * r;
                    v4u w; w.x = pg8::cvt_pk_bf16(v0[0], v0[1]); w.y = pg8::cvt_pk_bf16(v0[2], v0[3]); w.z = pg8::cvt_pk_bf16(v1[0], v1[1]); w.w = pg8::cvt_pk_bf16(v1[2], v1[3]);
                    *(v4u*)(P + (size_t)row * INW + col0 + bj * 128) = w; }
            }
    }
};
struct EpiVT {
    static constexpr bool PERM = false, AFTER_DRAIN = false;
    bf16* VT; const float* ssx; float* vs;
    __device__ __forceinline__ void operator()(const pg8::f32x4 (&acc)[2][2][4][2], const pg8::Unit& u, int wr, int wc, int fr, int fq) const {
        const int rowb = u.pm * 256 + wr * 64 + 4 * fq, cb = u.pn * 256 - C_V + wc * 32 + fr;
        pg8::f32x4 rs[2][4];
#pragma unroll
        for (int ai = 0; ai < 2; ++ai)
#pragma unroll
            for (int m = 0; m < 4; ++m) rs[ai][m] = *(const pg8::f32x4*)(ssx + rowb + ai * 128 + m * 16);
#pragma unroll
        for (int ai = 0; ai < 2; ++ai)
#pragma unroll
            for (int m = 0; m < 4; ++m) {
                const int row = rowb + ai * 128 + m * 16;
                pg8::f32x4 r;
#pragma unroll
                for (int e = 0; e < 4; ++e) r[e] = __builtin_amdgcn_rsqf(rs[ai][m][e] * (1.0f / DM) + EPS);
#pragma unroll
                for (int bj = 0; bj < 2; ++bj)
#pragma unroll
                    for (int n = 0; n < 2; ++n) { const int c = cb + bj * 128 + n * 16; const pg8::f32x4 v = acc[ai][bj][m][n] * r;
                        u32x2 w; w.x = pg8::cvt_pk_bf16(v[0], v[1]); w.y = pg8::cvt_pk_bf16(v[2], v[3]);
                        *(u32x2*)(VT + ((size_t)(row >> 6) * 768 + c) * 64 + (row & 63)) = w;
                        if (row >= MP) { float* o = vs + (size_t)(row - MP) * 768 + c; o[0] = v[0]; o[768] = v[1]; o[2 * 768] = v[2]; o[3 * 768] = v[3]; } }
            }
    }
};
struct EpiD {
    static constexpr bool PERM = true, AFTER_DRAIN = false;
    bf16* D16; bf16* DSL;
    __device__ __forceinline__ void operator()(const pg8::f32x4 (&acc)[2][2][4][2], const pg8::Unit& u, int wr, int wc, int fr, int fq) const {
        const int row0 = u.pm * 256 + wr * 64 + fr, col0 = u.pn * 256 + wc * 32 + 8 * fq;
        bf16* base = (u.slab == 0) ? D16 : DSL + ((size_t)(u.slab - 1) * MS - MP) * DM;
#pragma unroll
        for (int ai = 0; ai < 2; ++ai)
#pragma unroll
            for (int m = 0; m < 4; ++m) { bf16* rowp = base + (size_t)(row0 + ai * 128 + m * 16) * DM + col0;
#pragma unroll
                for (int bj = 0; bj < 2; ++bj) { const pg8::f32x4 v0 = acc[ai][bj][m][0], v1 = acc[ai][bj][m][1];
                    v4u w; w.x = pg8::cvt_pk_bf16(v0[0], v0[1]); w.y = pg8::cvt_pk_bf16(v0[2], v0[3]); w.z = pg8::cvt_pk_bf16(v1[0], v1[1]); w.w = pg8::cvt_pk_bf16(v1[2], v1[3]);
                    *(v4u*)(rowp + bj * 128) = w; } }
    }
};

__device__ __forceinline__ void cvt_item(const float* W, int K, int N, const float* gain, bf16* WT, int sh, int add, LAS unsigned char* scr, int item, int lane) {
    const int nblk2 = N >> 8, q = item >> 3, r8 = item & 7, qk = q / nblk2, kb = 4 * qk + (r8 >> 1), nb = 2 * (q - qk * nblk2) + (r8 & 1), k0 = kb << 6, n00 = nb << 7;
    const int kq = lane >> 4, nq = lane & 15;
    const float* src = W + (size_t)(k0 + 16 * kq) * N + n00 + 4 * nq;
    f32x4 v[2][16];
#pragma unroll
    for (int i = 0; i < 16; ++i) { v[0][i] = __builtin_nontemporal_load((const f32x4*)(src + (size_t)i * N)); v[1][i] = __builtin_nontemporal_load((const f32x4*)(src + (size_t)i * N + 64)); }
    f32x4 g4[4];
    if (gain) { const f32x4* gp = (const f32x4*)(gain + k0 + 16 * kq);
#pragma unroll
        for (int i4 = 0; i4 < 4; ++i4) g4[i4] = gp[i4]; }
    else {
#pragma unroll
        for (int i4 = 0; i4 < 4; ++i4) g4[i4] = (f32x4){1.f, 1.f, 1.f, 1.f}; }
    const int r = lane >> 3, c8 = lane & 7;
#pragma unroll
    for (int hf = 0; hf < 2; ++hf) {
        const int n0 = n00 + 64 * hf;
#pragma unroll
        for (int c = 0; c < 4; ++c) {
            float t[16];
#pragma unroll
            for (int i = 0; i < 16; ++i) t[i] = v[hf][i][c] * g4[i >> 2][i & 3];
            v4u lo, hi;
            lo.x = pg8::cvt_pk_bf16(t[0], t[1]); lo.y = pg8::cvt_pk_bf16(t[2], t[3]); lo.z = pg8::cvt_pk_bf16(t[4], t[5]); lo.w = pg8::cvt_pk_bf16(t[6], t[7]);
            hi.x = pg8::cvt_pk_bf16(t[8], t[9]); hi.y = pg8::cvt_pk_bf16(t[10], t[11]); hi.z = pg8::cvt_pk_bf16(t[12], t[13]); hi.w = pg8::cvt_pk_bf16(t[14], t[15]);
            LAS unsigned char* p = scr + (4 * nq + c) * 144 + 32 * kq;
            *(LAS v4u*)p = lo; *(LAS v4u*)(p + 16) = hi;
        }
        LDS_WAIT(); asm volatile("" ::: "memory");
#pragma unroll
        for (int j = 0; j < 8; ++j) { const int n = 8 * j + r; const v4u o = *(const LAS v4u*)(scr + n * 144 + 16 * c8);
            const int nn = n0 + n, orow = ((nn >> 7) << sh) + add + (nn & 127);
            *(v4u*)(WT + (size_t)orow * K + k0 + 8 * c8) = o; }
        LDS_WAIT(); asm volatile("" ::: "memory");
    }
}

__device__ __forceinline__ void ew_phase(float* Y, bf16* XB, float* SSX, const bf16* D16, const bf16* DSL, const float* gain, float alpha, bool last, int gw, int ngw, int lane) {
    for (int row = gw; row < M; row += ngw) {
        f32x4 dv[8];
        if (row < MP) { const u32x2* dr = (const u32x2*)(D16 + (size_t)row * DM) + lane;
#pragma unroll
            for (int j = 0; j < 8; ++j) { float t[4]; unpack4(dr[64 * j], t); dv[j] = (f32x4){t[0], t[1], t[2], t[3]}; } }
        else { const u32x2* dr = (const u32x2*)(DSL + (size_t)(row - MP) * DM) + lane;
#pragma unroll
            for (int j = 0; j < 8; ++j) { float t0[4], t1[4], t2[4], t3[4]; unpack4(dr[64 * j], t0); unpack4(dr[64 * j + (size_t)MS * DM / 4], t1); unpack4(dr[64 * j + (size_t)2 * MS * DM / 4], t2); unpack4(dr[64 * j + (size_t)3 * MS * DM / 4], t3);
                dv[j] = (f32x4){(t0[0] + t1[0]) + (t2[0] + t3[0]), (t0[1] + t1[1]) + (t2[1] + t3[1]), (t0[2] + t1[2]) + (t2[2] + t3[2]), (t0[3] + t1[3]) + (t2[3] + t3[3])}; } }
        const f32x4* gr = (const f32x4*)gain + lane; u32x2* xb = (u32x2*)(XB + (size_t)row * DM) + lane;
        f32x4 xv[8]; float sd = 0.f;
#pragma unroll
        for (int j = 0; j < 8; ++j) { float t[4]; unpack4(xb[64 * j], t); xv[j] = (f32x4){t[0], t[1], t[2], t[3]}; const f32x4 d = dv[j]; sd += (d[0] * d[0] + d[1] * d[1]) + (d[2] * d[2] + d[3] * d[3]); }
        sd = wave_sum(sd, lane);
        const float sc = __builtin_amdgcn_rsqf(sd * (1.0f / DM) + EPS) * alpha;
        float ss = 0.f;
        if (!last) {
#pragma unroll
            for (int j = 0; j < 8; ++j) { const f32x4 g = gr[64 * j]; const f32x4 x = xv[j] + dv[j] * g * sc;
                u32x2 w; w.x = pg8::cvt_pk_bf16(x[0], x[1]); w.y = pg8::cvt_pk_bf16(x[2], x[3]); xb[64 * j] = w; ss += (x[0] * x[0] + x[1] * x[1]) + (x[2] * x[2] + x[3] * x[3]); }
            ss = wave_sum(ss, lane); if (lane == 0) SSX[row] = ss;
        } else { f32x4* yr = (f32x4*)(Y + (size_t)row * DM) + lane;
#pragma unroll
            for (int j = 0; j < 8; ++j) { const f32x4 g = gr[64 * j]; yr[64 * j] = xv[j] + dv[j] * g * sc; } }
    }
}

template <int W>
__device__ __forceinline__ bf16x8 pool_frag_fast(const bf16* ub  , int loff  ) {
    bf16x8 q[W];
#pragma unroll
    for (int jj = 0; jj < W; ++jj) q[jj] = *(const bf16x8*)(ub - (size_t)jj * INW + loff);
    float s[8], p0[8]; unpack8(q[0], p0);
#pragma unroll
    for (int i = 0; i < 8; ++i) s[i] = p0[i];
#pragma unroll
    for (int jj = 1; jj < W; ++jj) { float v[8]; unpack8(q[jj], v);
#pragma unroll
        for (int i = 0; i < 8; ++i) s[i] += v[i]; }
    bf16x8 d;
#pragma unroll
    for (int i = 0; i < 8; ++i) d[i] = (short)f2bf(s[i] * (1.0f / W) - p0[i]);
    return d;
}
template <int W>
__device__ __forceinline__ bf16x8 pool_frag_first(const bf16* ub  , const float* hb  , bool samp, int tr, int kq) {
    bf16x8 q[W];
#pragma unroll
    for (int jj = 0; jj < W; ++jj) { const int tt = tr - jj; q[jj] = *(const bf16x8*)(ub + (tt < 0 ? 0 : tt) * INW + 8 * kq); }
    float s[8], p0[8]; unpack8(q[0], p0);
#pragma unroll
    for (int i = 0; i < 8; ++i) s[i] = p0[i];
#pragma unroll
    for (int jj = 1; jj < W; ++jj) { float v[8]; unpack8(q[jj], v); const bool ok = tr >= jj;
#pragma unroll
        for (int i = 0; i < 8; ++i) s[i] += ok ? v[i] : 0.f; }
    float invc = 1.0f / (float)((tr + 1) < W ? (tr + 1) : W);
    if (samp) {
        constexpr int GRP = 5;
#pragma unroll
        for (int j0 = 1; j0 < W; j0 += GRP) {
            __builtin_amdgcn_sched_barrier(0);
            f32x4 ha[GRP], hc[GRP];
#pragma unroll
            for (int k = 0; k < GRP; ++k) if (j0 + k < W) { const int hr = 15 + tr - (j0 + k); const float* hp = hb + (hr > 14 ? 14 : hr) * 512 + 8 * kq; ha[k] = *(const f32x4*)hp; hc[k] = *(const f32x4*)(hp + 4); }
#pragma unroll
            for (int k = 0; k < GRP; ++k) if (j0 + k < W) { const bool use = tr < j0 + k;
#pragma unroll
                for (int i = 0; i < 4; ++i) { s[i] += use ? ha[k][i] : 0.f; s[4 + i] += use ? hc[k][i] : 0.f; } }
        }
        invc = 1.0f / (float)W;
    }
    bf16x8 d;
#pragma unroll
    for (int i = 0; i < 8; ++i) d[i] = (short)f2bf(s[i] * invc - p0[i]);
    return d;
}
__device__ __forceinline__ float pool_compute(int l, int tb, int g, const bf16* PROJ, const float* state_pool, const bf16* POOLW, f32x4 (&acc)[8], int lane) {
    asm volatile("" : "+v"(lane));
    const int r0 = tb * 16, tr = lane & 15, kq = lane >> 4;
    const bool samp = r0 >= MP;
    int seq0, tloc0, sb = 0;
    if (!samp) { seq0 = r0 & ~(SEQ - 1); tloc0 = r0 & (SEQ - 1); } else { sb = (r0 - MP) >> 6; seq0 = MP + (sb << 6); tloc0 = (r0 - MP) & 63; }
    bf16x8 dfr[4];
    const bf16* pb = PROJ + (size_t)(seq0 + tloc0) * INW + C_P + g * 128;
    const int loff = tr * INW + 8 * kq;
    if (tloc0 == 0) {
        const float* hb = state_pool + (size_t)(l * DB + sb) * 15 * 512 + g * 128;
#pragma unroll
        for (int kt = 0; kt < 4; ++kt) {
            if (g == 0) dfr[kt] = pool_frag_first<2>(pb + 32 * kt, hb + 32 * kt, samp, tr, kq);
            else if (g == 1) dfr[kt] = pool_frag_first<4>(pb + 32 * kt, hb + 32 * kt, samp, tr, kq);
            else if (g == 2) dfr[kt] = pool_frag_first<8>(pb + 32 * kt, hb + 32 * kt, samp, tr, kq);
            else dfr[kt] = pool_frag_first<16>(pb + 32 * kt, hb + 32 * kt, samp, tr, kq);
            __builtin_amdgcn_sched_barrier(0);
        }
    } else if (g == 0) {
#pragma unroll
        for (int kt = 0; kt < 4; ++kt) dfr[kt] = pool_frag_fast<2>(pb + 32 * kt, loff);
    } else if (g == 1) {
#pragma unroll
        for (int kt = 0; kt < 4; ++kt) dfr[kt] = pool_frag_fast<4>(pb + 32 * kt, loff);
    } else if (g == 2) {
#pragma unroll
        for (int kt = 0; kt < 4; ++kt) dfr[kt] = pool_frag_fast<8>(pb + 32 * kt, loff);
    } else {
#pragma unroll
        for (int kt = 0; kt < 4; ++kt) { dfr[kt] = pool_frag_fast<16>(pb + 32 * kt, loff); if (kt == 1) __builtin_amdgcn_sched_barrier(0); }
    }
#pragma unroll
    for (int dt = 0; dt < 8; ++dt) acc[dt] = (f32x4){0.f, 0.f, 0.f, 0.f};
    const bf16* Wg = POOLW + (size_t)(l * 4 + g) * 128 * 128; const int woff = tr * 128 + 8 * kq;
    bf16x8 wf[4][8];
#pragma unroll
    for (int kt = 0; kt < 4; ++kt)
#pragma unroll
        for (int dt = 0; dt < 8; ++dt) wf[kt][dt] = *(const bf16x8*)(Wg + (16 * dt) * 128 + 32 * kt + woff);
    __builtin_amdgcn_sched_barrier(0);
#pragma unroll
    for (int kt = 0; kt < 4; ++kt)
#pragma unroll
        for (int dt = 0; dt < 8; ++dt) acc[dt] = __builtin_amdgcn_mfma_f32_16x16x32_bf16(wf[kt][dt], dfr[kt], acc[dt], 0, 0, 0);
    __builtin_amdgcn_sched_barrier(0);
    float ss = 0.f;
#pragma unroll
    for (int dt = 0; dt < 8; ++dt) { const f32x4 a = acc[dt]; ss += (a[0] * a[0] + a[1] * a[1]) + (a[2] * a[2] + a[3] * a[3]); }
    ss += shx(ss, 16, lane); ss += shx(ss, 32, lane);
    return ss;
}
__device__ __forceinline__ void tile_store(const f32x4 (&v)[8], float r, bf16* dst  ) {
#pragma unroll
    for (int dt = 0; dt < 8; ++dt) { const f32x4 a = v[dt] * r; u32x2 o; o.x = pg8::cvt_pk_bf16(a[0], a[1]); o.y = pg8::cvt_pk_bf16(a[2], a[3]); *(u32x2*)(dst + 16 * dt) = o; }
}
__device__ __forceinline__ void conv_z(int l, int seq0, int tt, bool samp, int sb, int c, const bf16* PROJ, const float* state_conv, float (&z)[4]) {
    if (tt >= 0) { float h[4], cg[4]; unpack4(*(const u32x2*)(PROJ + (size_t)(seq0 + tt) * INW + C_H + c), h); unpack4(*(const u32x2*)(PROJ + (size_t)(seq0 + tt) * INW + C_CG + c), cg);
#pragma unroll
        for (int i = 0; i < 4; ++i) z[i] = cg[i] * h[i]; }
    else if (samp) { const f32x4 a = *(const f32x4*)(state_conv + ((size_t)(l * DB + sb) * 2 + 2 + tt) * 768 + c); z[0] = a[0]; z[1] = a[1]; z[2] = a[2]; z[3] = a[3]; }
    else { z[0] = 0.f; z[1] = 0.f; z[2] = 0.f; z[3] = 0.f; }
}
__device__ __forceinline__ void conv_quad(int l, int q, const bf16* PROJ, const float* state_conv, const float* conv_w, bf16* YU, int lane) {
    asm volatile("" : "+v"(lane));
    const int row0 = 4 * q; const bool samp = row0 >= MP; int seq0, tloc0, sb = 0;
    if (!samp) { seq0 = row0 & ~(SEQ - 1); tloc0 = row0 & (SEQ - 1); } else { sb = (row0 - MP) >> 6; seq0 = MP + (sb << 6); tloc0 = (row0 - MP) & 63; }
    float ss[4] = {0.f, 0.f, 0.f, 0.f}; float y[3][4][4];
#pragma unroll
    for (int j = 0; j < 3; ++j) {
        const int c = 256 * j + 4 * lane;
        float zz[6][4];
#pragma unroll
        for (int k = 0; k < 6; ++k) conv_z(l, seq0, tloc0 - 2 + k, samp, sb, c, PROJ, state_conv, zz[k]);
        u32x2 bgr[4];
#pragma unroll
        for (int i = 0; i < 4; ++i) bgr[i] = *(const u32x2*)(PROJ + (size_t)(row0 + i) * INW + C_BG + c);
        const f32x4 w0 = *(const f32x4*)(conv_w + (size_t)(l * 3 + 0) * 768 + c), w1 = *(const f32x4*)(conv_w + (size_t)(l * 3 + 1) * 768 + c), w2 = *(const f32x4*)(conv_w + (size_t)(l * 3 + 2) * 768 + c);
#pragma unroll
        for (int i = 0; i < 4; ++i) { float bg[4]; unpack4(bgr[i], bg);
#pragma unroll
            for (int e = 0; e < 4; ++e) { const float v = bg[e] * (zz[i][e] * w0[e] + zz[i + 1][e] * w1[e] + zz[i + 2][e] * w2[e]); y[j][i][e] = v; ss[i] += v * v; } }
    }
#pragma unroll
    for (int i = 0; i < 4; ++i) { const float r = __builtin_amdgcn_rsqf(wave_sum(ss[i], lane) * (1.0f / 768.0f) + EPS);
#pragma unroll
        for (int j = 0; j < 3; ++j) { u32x2 o; o.x = pg8::cvt_pk_bf16(y[j][i][0] * r, y[j][i][1] * r); o.y = pg8::cvt_pk_bf16(y[j][i][2] * r, y[j][i][3] * r);
            *(u32x2*)(YU + (size_t)(row0 + i) * DM + 512 + 256 * j + 4 * lane) = o; } }
}
__device__ __forceinline__ void sgu_chunk(int l, int cu, const bf16* PROJ, const bf16* VT, const bf16* SGUW, const float* sgu_b, bf16* YU, LAS unsigned char* vbuf, int wave, int lane) {
    const bool samp = cu >= 128;
    const int chunk0 = samp ? (MP + (cu - 128) * DSEQ) : cu * 128, nst = samp ? 4 : 8, npc = samp ? 2 : 4;
    const int tid = wave * 64 + lane, tr = lane & 15, kq = lane >> 4;
    const int s0 = 16 * wave; const bool active = wave < nst; const int row = chunk0 + s0 + tr;
    const int nk = (s0 + 47) >> 5;
    const bf16* vsrc = VT + (size_t)(chunk0 >> 6) * 768 * 64;
    v4u st[4];
#pragma unroll
    for (int i = 0; i < 4; ++i) if (i < npc) { const int q = tid + 512 * i; st[i] = *(const v4u*)(vsrc + (size_t)(q >> 10) * 768 * 64 + (q & 1023) * 8); } else st[i] = (v4u){0u, 0u, 0u, 0u};
#pragma unroll
    for (int i = 0; i < 4; ++i) if (i < npc) *(LAS v4u*)(vbuf + (tid + 512 * i) * 16) = st[i];
    LDS_WAIT(); __builtin_amdgcn_s_barrier(); asm volatile("" ::: "memory");
    u32x2 ypk[6][8]; float ss = 0.f;
#pragma unroll
    for (int h = 0; h < 6; ++h) {
        if (h + 1 < 6) {
#pragma unroll
            for (int i = 0; i < 4; ++i) if (i < npc) { const int q = tid + 512 * i; st[i] = *(const v4u*)(vsrc + (size_t)(h + 1) * 128 * 64 + (size_t)(q >> 10) * 768 * 64 + (q & 1023) * 8); }
        }
        const LAS unsigned char* vb = vbuf + (h & 1) * 32768 + tr * 128 + kq * 16;
        if (active) {
            u32x2 uraw[8];
#pragma unroll
            for (int ct = 0; ct < 8; ++ct) uraw[ct] = *(const u32x2*)(PROJ + (size_t)row * INW + C_U + h * 128 + 16 * ct + 4 * kq);
            const float bias = sgu_b[(size_t)(l * 6 + h) * 128 + s0 + tr];
            const bf16* Wrow = SGUW + ((size_t)(l * 6 + h) * 128 + s0) * 128 + tr * 128 + 8 * kq;
            bf16x8 wf[4];
#pragma unroll
            for (int kt = 0; kt < 4; ++kt) wf[kt] = (kt < nk) ? *(const bf16x8*)(Wrow + 32 * kt) : (bf16x8){0, 0, 0, 0, 0, 0, 0, 0};
            f32x4 acc[8];
#pragma unroll
            for (int ct = 0; ct < 8; ++ct) acc[ct] = (f32x4){0.f, 0.f, 0.f, 0.f};
#pragma unroll
            for (int kt = 0; kt < 4; ++kt) if (kt < nk) {
#pragma unroll
                for (int ct = 0; ct < 8; ++ct) { const bf16x8 vf = *(const LAS bf16x8*)(vb + (kt >> 1) * 16384 + (kt & 1) * 64 + ct * 2048);
                    acc[ct] = __builtin_amdgcn_mfma_f32_16x16x32_bf16(vf, wf[kt], acc[ct], 0, 0, 0); }
            }
#pragma unroll
            for (int ct = 0; ct < 8; ++ct) { float uu[4], y[4]; unpack4(uraw[ct], uu);
#pragma unroll
                for (int i = 0; i < 4; ++i) { y[i] = uu[i] * (acc[ct][i] + bias); ss += y[i] * y[i]; }
                ypk[h][ct].x = pg8::cvt_pk_bf16(y[0], y[1]); ypk[h][ct].y = pg8::cvt_pk_bf16(y[2], y[3]); }
        } else {
#pragma unroll
            for (int ct = 0; ct < 8; ++ct) ypk[h][ct] = (u32x2){0u, 0u};
        }
        if (h + 1 < 6) {
#pragma unroll
            for (int i = 0; i < 4; ++i) if (i < npc) *(LAS v4u*)(vbuf + ((h + 1) & 1) * 32768 + (tid + 512 * i) * 16) = st[i];
        }
        LDS_WAIT(); __builtin_amdgcn_s_barrier(); asm volatile("" ::: "memory");
    }
    if (active) {
        ss += shx(ss, 16, lane); ss += shx(ss, 32, lane);
        const float r = __builtin_amdgcn_rsqf(ss * (1.0f / 768.0f) + EPS);
#pragma unroll
        for (int h = 0; h < 6; ++h)
#pragma unroll
            for (int ct = 0; ct < 8; ++ct) { float y[4]; unpack4(ypk[h][ct], y); u32x2 o; o.x = pg8::cvt_pk_bf16(y[0] * r, y[1] * r); o.y = pg8::cvt_pk_bf16(y[2] * r, y[3] * r);
                *(u32x2*)(YU + (size_t)row * DM + 1280 + h * 128 + 16 * ct + 4 * kq) = o; }
    }
}

constexpr int I_BIG = (DM / 64) * (DFF / 128), I_IN = (DM / 64) * (INW / 128), I_OUT = (DM / 64) * (DM / 128), I_LAYER = 6 * I_BIG + I_IN + I_OUT;
static_assert(I_BIG == (DFF / 64) * (DM / 128) && DFF % 128 == 0 && INW % 128 == 0, "gate/up and down item counts match");
constexpr int GU_UNITS = (M / 256) * (2 * DFF / 256), TAIL_WG0 = GU_UNITS - (GU_UNITS / 256) * 256, TAIL_WAVES = (256 - TAIL_WG0) * NWAVES, TAIL_N = 2, TAIL_ITEMS = TAIL_WAVES * TAIL_N;
static_assert(TAIL_WG0 == 96 && 2 * TAIL_ITEMS <= I_LAYER, "tail conversion split");
__device__ __forceinline__ void cvt_layer_item(const float* const* in, unsigned char* ws, int l, int r, LAS unsigned char* scr, int lane) {
    const float* norm_gains = in[17];
    const float* W; const float* gain; bf16* WT; int K, N, sh = 7, add = 0;
    if (r < 4 * I_BIG) { const int j = r / I_BIG; r -= j * I_BIG; const int f = j >> 1, up = j & 1;
        W = in[11 + 3 * f + up] + (size_t)l * DM * DFF; gain = norm_gains + (size_t)(l * 6 + 4 * f) * DM; WT = (bf16*)(ws + WS_WGU) + (size_t)(2 * l + f) * (2 * DFF * DM); K = DM; N = DFF; sh = 8; add = 128 * up; }
    else if (r < 6 * I_BIG) { r -= 4 * I_BIG; const int f = r / I_BIG; r -= f * I_BIG;
        W = in[13 + 3 * f] + (size_t)l * DFF * DM; gain = nullptr; WT = (bf16*)(ws + WS_WD) + (size_t)(2 * l + f) * (DM * DFF); K = DFF; N = DM; }
    else if (r < 6 * I_BIG + I_IN) { r -= 6 * I_BIG; W = in[4] + (size_t)l * DM * INW; gain = norm_gains + (size_t)(l * 6 + 2) * DM; WT = (bf16*)(ws + WS_WIN) + (size_t)l * (INW * DM); K = DM; N = INW; }
    else { r -= 6 * I_BIG + I_IN; W = in[5] + (size_t)l * DM * DM; gain = in[18] + (size_t)l * DM; WT = (bf16*)(ws + WS_WOUT) + (size_t)l * (DM * DM); K = DM; N = DM; }
    cvt_item(W, K, N, gain, WT, sh, add, scr, r, lane);
}

struct Args { const float* in[19]; float* out; unsigned char* ws; int step_lo, step_hi, use_bar, pad; };
constexpr int N_STEPS = 1 + 8 * 8;
#ifndef GP_ALIGN
#define GP_ALIGN true
#endif
#ifndef GP_SP2
#define GP_SP2 true
#endif
#ifndef MIXP
#define MIXP 0
#endif
#ifndef PROBE_DUP
#define PROBE_DUP 0
#endif
#define REPS(bit) (((PROBE_DUP >> (bit)) & 1) ? 2 : 1)
#define PHASE_ENV \
    int z_ = 0; asm volatile("" : "+s"(z_)); \
    const int lane = (int)__builtin_amdgcn_mbcnt_hi(~0u, __builtin_amdgcn_mbcnt_lo(~0u, (unsigned)z_)); \
    const int wave = __builtin_amdgcn_readfirstlane(wave0 + z_); const int tid = wave * 64 + lane; \
    const int G = (int)gridDim.x, bx = (int)blockIdx.x + z_; \
    const int vcu = (G % 8 == 0) ? (bx % 8) * (G / 8) + bx / 8 : bx; \
    const int gw = vcu * NWAVES + wave, ngw = G * NWAVES; \
    unsigned char* ws = args.ws + z_; float* out = args.out + z_; float* X = out; \
    bf16* XB = (bf16*)(ws + WS_XB); bf16* HB = (bf16*)(ws + WS_H); bf16* PROJ = HB; bf16* D16 = (bf16*)(ws + WS_D); bf16* DSL = (bf16*)(ws + WS_DSL); bf16* YU = (bf16*)(ws + WS_YU); \
    float* SSX = (float*)(ws + WS_SSX); \
    (void)lane; (void)tid; (void)gw; (void)ngw; (void)X; (void)XB; (void)HB; (void)PROJ; (void)D16; (void)DSL; (void)YU; (void)SSX; (void)bx;

__global__ void __launch_bounds__(NWAVES * 64, 2) fwd(Args args) {
    extern __shared__ __attribute__((aligned(16))) unsigned char lds_raw[];
    LAS unsigned char* lds = (LAS unsigned char*)lds_raw;
    volatile LAS unsigned* MISC = (volatile LAS unsigned*)(lds + MISC_OFF);
    const int wave0 = __builtin_amdgcn_readfirstlane((int)threadIdx.x >> 6);
    for (int u = threadIdx.x; u < (LDS_BYTES - MISC_OFF) / 4; u += NWAVES * 64) MISC[u] = 0u;
    __syncthreads();
    XcdBarrier bar; bar.bar = (unsigned*)(args.ws + WS_CTL) + CW_BAR; bar.x = 0; bar.st = nullptr;
    if (args.use_bar) bar = xcd_barrier_post((unsigned*)(args.ws + WS_CTL) + CW_BAR, MISC + 8);
#define GRID_BAR() do { if (args.use_bar) xcd_barrier(bar, tid == 0); } while (0)
    const int lo = args.step_lo, hi = args.step_hi;
#define IN(k) (lo <= (k) && (k) < hi)

    if (IN(0)) for (int rep = 0; rep < REPS(0); ++rep) {
        PHASE_ENV
        bf16* POOLW = (bf16*)(ws + WS_POOLW); bf16* SGUW = (bf16*)(ws + WS_SGUW);
        LAS unsigned char* scr = lds + wave * 16384;
        constexpr int I_REST = I_LAYER - 2 * TAIL_ITEMS;
        for (int it = gw; it < I_LAYER + (NLAYER - 1) * I_REST; it += ngw) {
            int l = 0, r = it;
            if (it >= I_LAYER) { l = 1 + (it - I_LAYER) / I_REST; r = 2 * TAIL_ITEMS + (it - I_LAYER) % I_REST; }
            cvt_layer_item(args.in, ws, l, r, scr, lane);
        }
        const int gt = vcu * (NWAVES * 64) + tid, ngt = G * NWAVES * 64;
        const float* pool_w = args.in[6]; const float* pool_scale = args.in[7]; const float* sgu_w = args.in[9];
        for (int o = gt; o < NLAYER * 4 * 128 * 128; o += ngt) {
            const int c = o & 127, d = (o >> 7) & 127, lg = o >> 14; POOLW[o] = (bf16)f2bf(pool_w[((size_t)lg * 128 + c) * 128 + d] * pool_scale[(size_t)lg * 128 + d]); }
        for (int o = gt; o < NLAYER * 6 * 128 * 128; o += ngt) {
            const int t = o & 127, sr = (o >> 7) & 127; SGUW[o] = (t <= sr) ? (bf16)f2bf(sgu_w[o]) : (bf16)0; }
        const float* x_prompt = args.in[0]; const float* x_sample = args.in[1];
        for (int row = gw; row < M; row += ngw) {
            const f32x4* src = (const f32x4*)(row < MP ? x_prompt + (size_t)row * DM : x_sample + (size_t)(row - MP) * DM) + lane;
            u32x2* xb = (u32x2*)(XB + (size_t)row * DM) + lane; float ss = 0.f;
#pragma unroll
            for (int j = 0; j < 8; ++j) { const f32x4 x = src[64 * j]; u32x2 w; w.x = pg8::cvt_pk_bf16(x[0], x[1]); w.y = pg8::cvt_pk_bf16(x[2], x[3]); xb[64 * j] = w;
                ss += (x[0] * x[0] + x[1] * x[1]) + (x[2] * x[2] + x[3] * x[3]); }
            ss = wave_sum(ss, lane); if (lane == 0) SSX[row] = ss;
        }
        GRID_BAR();
    }

    for (int s = 0; s < 8; ++s) {
        const int l = s >> 1, f = s & 1, base = 1 + s * 8;
        if (IN(base + 0)) for (int rep = 0; rep < REPS(1); ++rep) {
            PHASE_ENV
            pg8::Gemm g{XB, (bf16*)(ws + WS_WGU) + (size_t)s * (2 * DFF * DM), M, 2 * DFF, DM}; pg8::StaticOrder S; S.init(M, 2 * DFF, DM, G, bx);
            EpiGateUp E{HB, SSX};
            pg8::gemm_phase<EpiGateUp, pg8::StaticOrder, GP_ALIGN, GP_SP2>(lds, g, S, E, tid);
            if (l + 1 < NLAYER && bx >= TAIL_WG0 && rep == 0) {
                const int widx = (bx - TAIL_WG0) * NWAVES + wave;
                for (int k = 0; k < TAIL_N; ++k) cvt_layer_item(args.in, ws, l + 1, f * TAIL_ITEMS + k * TAIL_WAVES + widx, lds + wave * 16384, lane);
            }
            GRID_BAR();
        }
        if (IN(base + 1)) for (int rep = 0; rep < REPS(2); ++rep) {
            PHASE_ENV
            pg8::Gemm g{HB, (bf16*)(ws + WS_WD) + (size_t)s * (DM * DFF), M, DM, DFF}; pg8::SplitOrder S; S.init(DFF, bx);
            EpiD E{D16, DSL};
            pg8::gemm_phase<EpiD, pg8::SplitOrder, GP_ALIGN, GP_SP2>(lds, g, S, E, tid);
            GRID_BAR();
        }
        if (IN(base + 2)) for (int rep = 0; rep < REPS(3); ++rep) { PHASE_ENV ew_phase(X, XB, SSX, D16, DSL, args.in[17] + (size_t)(l * 6 + (f ? 5 : 1)) * DM, (rep + 1 == REPS(3)) ? 0.5f : 0.0f, s == 7 && rep + 1 == REPS(3), gw, ngw, lane); if (s != 7) GRID_BAR(); }
        if (f == 0) {
            if (IN(base + 3)) for (int rep = 0; rep < REPS(4); ++rep) {
                PHASE_ENV
                pg8::Gemm g{XB, (bf16*)(ws + WS_WIN) + (size_t)l * (INW * DM), M, INW, DM};
                { pg8::StaticOrder S; S.init(M, C_V, DM, G, bx, 0); EpiProj E{PROJ, SSX};
                  pg8::gemm_phase<EpiProj, pg8::StaticOrder, GP_ALIGN, GP_SP2>(lds, g, S, E, tid); }
                { pg8::StaticOrder S; S.init(M, INW - C_V, DM, G, bx, C_V / 256); EpiVT E{(bf16*)(ws + WS_VT), SSX, out + O_VS + (size_t)l * MS * 768};
                  pg8::gemm_phase<EpiVT, pg8::StaticOrder, GP_ALIGN, GP_SP2, true>(lds, g, S, E, tid); }
                GRID_BAR();
            }
            if (IN(base + 4)) for (int rep = 0; rep < REPS(5); ++rep) {
                {
                PHASE_ENV
                const float* state_pool = args.in[2]; const float* state_conv = args.in[3]; const float* conv_w = args.in[8]; const float* sgu_b = args.in[10];
                const bf16* POOLW = (const bf16*)(ws + WS_POOLW); const bf16* SGUW = (const bf16*)(ws + WS_SGUW);
                const bf16* VT = (const bf16*)(ws + WS_VT);
                if (vcu < 160) sgu_chunk(l, vcu, PROJ, VT, SGUW, sgu_b, YU, lds, wave, lane);
                LAS float* tab = (LAS float*)(lds + 65536); int par = 0;
                const int npass = (vcu >= 192) ? 3 : 2;
                for (int k = 0; k < npass; ++k, par ^= 1) {
                    int zp = 0; asm volatile("" : "+s"(zp));
                    const int ln = (int)__builtin_amdgcn_mbcnt_hi(~0u, __builtin_amdgcn_mbcnt_lo(~0u, (unsigned)zp));
                    const int tr = ln & 15, kq = ln >> 4, g = wave & 3;
                    int pass;
                    if (vcu < 160) pass = k * 256 + vcu;
                    else if (vcu < 192) pass = (k == 0) ? (512 + 2 * (vcu - 160)) : vcu;
                    else pass = (k == 0) ? vcu : (k == 1) ? (416 + vcu - 192) : ((vcu < 224) ? (480 + vcu - 192) : (513 + 2 * (vcu - 224)));
                    const int tb = 2 * pass + (wave >> 2);
                    LAS float* T = tab + par * 512 + (wave >> 2) * 256 + tr * 16; const int row = tb * 16 + tr;
                    f32x4 a0[8];
                    const float s0 = pool_compute(l, tb, g, PROJ, state_pool, POOLW, a0, ln); if (kq == 0) T[g] = s0;
                    conv_quad(l, tb * 4 + g, PROJ, state_conv, conv_w, YU, ln);
                    LDS_WAIT(); __builtin_amdgcn_s_barrier(); asm volatile("" ::: "memory");
                    const float r = __builtin_amdgcn_rsqf(((T[0] + T[1]) + (T[2] + T[3])) * (1.0f / 512.0f) + EPS);
                    tile_store(a0, r, YU + (size_t)row * DM + g * 128 + 4 * kq);
                }
                }
                {
                PHASE_ENV
                const int gt = vcu * (NWAVES * 64) + tid, ngt = G * NWAVES * 64;
                for (int o = gt; o < (2 + DB) * 15 * 512; o += ngt) { const int c = o & 511, ri = o >> 9, b = ri / 15, i = ri - b * 15;
                    if (b < 2) out[O_PP + ((size_t)(l * 2 + b) * 15 + i) * 512 + c] = bf2f(PROJ[(size_t)(b * SEQ + SEQ - 15 + i) * INW + C_P + c]);
                    else out[O_PS + ((size_t)(l * DB + (b - 2)) * 15 + i) * 512 + c] = bf2f(PROJ[(size_t)(MP + (b - 2) * DSEQ + DSEQ - 15 + i) * INW + C_P + c]); }
                for (int o = gt; o < (2 + DB) * 2 * 768; o += ngt) { const int c = o % 768, ri = o / 768, b = ri >> 1, i = ri & 1;
                    const size_t row = b < 2 ? (size_t)(b * SEQ + SEQ - 2 + i) : (size_t)(MP + (b - 2) * DSEQ + DSEQ - 2 + i);
                    const float zz = bf2f(PROJ[row * INW + C_CG + c]) * bf2f(PROJ[row * INW + C_H + c]);
                    if (b < 2) out[O_CP + ((size_t)(l * 2 + b) * 2 + i) * 768 + c] = zz; else out[O_CS + ((size_t)(l * DB + (b - 2)) * 2 + i) * 768 + c] = zz; }
                GRID_BAR();
                }
            }
            if (IN(base + 6)) for (int rep = 0; rep < REPS(6); ++rep) {
                PHASE_ENV
                pg8::Gemm g{YU, (bf16*)(ws + WS_WOUT) + (size_t)l * (DM * DM), M, DM, DM}; pg8::SplitOrder S; S.init(DM, bx);
                EpiD E{D16, DSL};
                pg8::gemm_phase<EpiD, pg8::SplitOrder, GP_ALIGN, GP_SP2>(lds, g, S, E, tid);
                GRID_BAR();
            }
            if (IN(base + 7)) for (int rep = 0; rep < REPS(3); ++rep) { PHASE_ENV ew_phase(X, XB, SSX, D16, DSL, args.in[17] + (size_t)(l * 6 + 3) * DM, (rep + 1 == REPS(3)) ? 1.0f : 0.0f, false, gw, ngw, lane); GRID_BAR(); }
        }
    }
#undef IN
#undef GRID_BAR
}

#ifndef MK_ONE_LAUNCH
#define MK_ONE_LAUNCH 1
#endif
extern "C" void kernel_launch(void* const* d_in, const int* in_sizes, int n_in, void* d_out, int out_size, void* d_ws, size_t ws_size, hipStream_t stream) {
    static int grid = 0;
    if (grid == 0) {
        if (n_in != 19 || out_size != (int)O_END || ws_size < WS_END) { fprintf(stderr, "kernel_launch: unexpected shapes: n_in %d out %d ws %zu (need %zu); nothing launched\n", n_in, out_size, ws_size, (size_t)WS_END); grid = -1; return; }
        int dev = 0, cus = 0, per_cu = 0;
        if (hipGetDevice(&dev) != hipSuccess || hipDeviceGetAttribute(&cus, hipDeviceAttributeMultiprocessorCount, dev) != hipSuccess) { fprintf(stderr, "kernel_launch: device query failed\n"); grid = -1; return; }
        if (hipFuncSetAttribute((const void*)fwd, hipFuncAttributeMaxDynamicSharedMemorySize, LDS_BYTES) != hipSuccess) { fprintf(stderr, "kernel_launch: hipFuncSetAttribute failed\n"); grid = -1; return; }
        if (hipOccupancyMaxActiveBlocksPerMultiprocessor(&per_cu, (const void*)fwd, NWAVES * 64, LDS_BYTES) != hipSuccess || per_cu < 1) { fprintf(stderr, "kernel_launch: occupancy query reports %d workgroups per CU\n", per_cu); }
        (void)hipGetLastError();
        if (cus != 256) { fprintf(stderr, "kernel_launch: built for a 256-CU device (the split-K unit deal), found %d CUs; nothing launched\n", cus); grid = -1; return; }
        grid = cus;
    }
    if (grid < 0) return;
    if (hipMemsetAsync((char*)d_ws + WS_CTL, 0, CTL_ZERO_BYTES, stream) != hipSuccess) { fprintf(stderr, "kernel_launch: memset failed\n"); return; }
    Args a{};
    for (int i = 0; i < 19; ++i) a.in[i] = (const float*)d_in[i];
    a.out = (float*)d_out; a.ws = (unsigned char*)d_ws;
#if MK_ONE_LAUNCH
    a.step_lo = 0; a.step_hi = N_STEPS; a.use_bar = 1;
    hipLaunchKernelGGL(fwd, dim3(grid), dim3(NWAVES * 64), LDS_BYTES, stream, a);
#else
    for (int st = 0; st < N_STEPS; ++st) {
        if (st > 0) { const int s = (st - 1) >> 3, p = (st - 1) & 7; if (((s & 1) && p >= 3) || p == 5) continue; }
        a.step_lo = st; a.step_hi = st + 1; a.use_bar = 0;
        hipLaunchKernelGGL(fwd, dim3(grid), dim3(NWAVES * 64), LDS_BYTES, stream, a);
    }
#endif
    const hipError_t le = hipPeekAtLastError();
    if (le != hipSuccess) fprintf(stderr, "kernel_launch: launch failed: %s\n", hipGetErrorName(le));
}
```
